# Optimizing an MI355X kernel written in HIP

```python
import math
import jax, jax.numpy as jnp
from jax import lax
import numpy as np

D_MODEL = 1024
BATCH = 2
SEQ = 16384
DEPTH = 1

A_HEADS = 8
A_KV_HEADS = 2
A_HEAD_DIM = 64
WINDOW = 128
BLK = WINDOW
A_WIDTH = A_HEADS * A_HEAD_DIM
NUM_BUCKETS = 32
T5_MAX_DIST = 128
B_HEADS = 4
Q_LORA = 256
KV_LORA = 128
NOPE_DIM = 128
ROPE_DIM = 64
V_DIM = 128
ROPE_THETA = 10000.0
QB = 128
B_WIDTH = B_HEADS * V_DIM
MIX_WIDTH = A_WIDTH + B_WIDTH
IN_SPLITS = (A_HEADS * A_HEAD_DIM, A_KV_HEADS * A_HEAD_DIM, A_KV_HEADS * A_HEAD_DIM,
             Q_LORA, KV_LORA, ROPE_DIM)
IN_COLS = sum(IN_SPLITS)
D_FF = 2816
CONV_W = 3
EPS = 1e-6
NEG = -1e30

kernel_name = "hymba_swa_sink_mla_convffn"


def rmsnorm(x, g):
    xf = x.astype(jnp.float32)
    y = xf * lax.rsqrt(jnp.mean(xf * xf, axis=-1, keepdims=True) + EPS)
    return (y * g.astype(jnp.float32)).astype(x.dtype)


def t5_bucket(dist):
    max_exact = NUM_BUCKETS // 2
    n = jnp.maximum(dist, 0)
    large = max_exact + (jnp.log(jnp.maximum(n, 1).astype(jnp.float32) / max_exact)
                         / math.log(T5_MAX_DIST / max_exact)
                         * (NUM_BUCKETS - max_exact)).astype(jnp.int32)
    large = jnp.minimum(large, NUM_BUCKETS - 1)
    return jnp.where(n < max_exact, n, large)


def rope(x, ang):
    half = x.shape[-1] // 2
    x1, x2 = x[..., :half].astype(jnp.float32), x[..., half:].astype(jnp.float32)
    c, s = jnp.cos(ang), jnp.sin(ang)
    return jnp.concatenate([x1 * c - x2 * s, x1 * s + x2 * c], axis=-1).astype(x.dtype)


def sliding_window_attention(q, k, v, sinks, bias_table):
    b, s, hq, dh = q.shape
    hkv = k.shape[2]
    g = hq // hkv
    nb = s // BLK
    qb = q.reshape(b, nb, BLK, hkv, g, dh)
    kb = k.reshape(b, nb, BLK, hkv, dh)
    vb = v.reshape(b, nb, BLK, hkv, dh)
    pad = jnp.zeros_like(kb[:, :1])
    kk = jnp.concatenate([jnp.concatenate([pad, kb[:, :-1]], axis=1), kb], axis=2)
    vv = jnp.concatenate([jnp.concatenate([pad, vb[:, :-1]], axis=1), vb], axis=2)
    scores = jnp.einsum('bnqhgd,bnkhd->bnhgqk', qb, kk).astype(jnp.float32) * (dh ** -0.5)
    q_idx = BLK + jnp.arange(BLK)
    k_idx = jnp.arange(2 * BLK)
    dist = q_idx[:, None] - k_idx[None, :]
    in_window = (dist >= 0) & (dist < WINDOW)
    not_pad = (jnp.arange(nb)[:, None, None] > 0) | (k_idx >= BLK)[None, None, :]
    mask = in_window[None] & not_pad
    bias = bias_table[t5_bucket(dist)].astype(jnp.float32)
    bias = jnp.transpose(bias, (2, 0, 1)).reshape(hkv, g, BLK, 2 * BLK)
    scores = jnp.where(mask[None, :, None, None], scores + bias, NEG)
    sink = sinks.astype(jnp.float32).reshape(1, 1, hkv, g, 1, 1)
    m = jnp.maximum(jnp.max(scores, axis=-1, keepdims=True), sink)
    p = jnp.exp(scores - m)
    denom = jnp.sum(p, axis=-1, keepdims=True) + jnp.exp(sink - m)
    out = jnp.einsum('bnhgqk,bnkhd->bnqhgd', (p / denom).astype(v.dtype), vv)
    return out.reshape(b, s, hq * dh)


def dense_causal_attention(q, k, v):
    b, s, h, dqk = q.shape
    dv = v.shape[-1]
    nb = s // QB
    scale = dqk ** -0.5
    k_pos = jnp.arange(s)

    def block(n):
        qs = lax.dynamic_slice_in_dim(q, n * QB, QB, axis=1)
        sc = jnp.einsum('bqhd,bkhd->bhqk', qs, k).astype(jnp.float32) * scale
        causal = (n * QB + jnp.arange(QB))[:, None] >= k_pos[None, :]
        p = jax.nn.softmax(jnp.where(causal, sc, NEG), axis=-1)
        return jnp.einsum('bhqk,bkhd->bqhd', p.astype(v.dtype), v)

    out = lax.map(block, jnp.arange(nb))
    return jnp.transpose(out, (1, 0, 2, 3, 4)).reshape(b, s, h * dv)


def causal_dwconv(u, w, bias):
    s = u.shape[1]
    up = jnp.pad(u, ((0, 0), (CONV_W - 1, 0), (0, 0)))
    return sum(up[:, j:j + s] * w[j] for j in range(CONV_W)) + bias


def setup_inputs(seed: int = 0) -> dict:
    key = jax.random.key(seed)
    ks = jax.random.split(key, 20)
    f32 = jnp.float32

    def w(k, shape, fan_in):
        return jax.random.normal(k, shape, f32) * fan_in ** -0.5

    def gain(k, shape):
        return 1.0 + 0.05 * jax.random.normal(k, shape, f32)

    x = jax.random.normal(ks[0], (BATCH, SEQ, D_MODEL), f32)
    offsets = jax.random.randint(ks[1], (BATCH, 1), 0, 4096, dtype=jnp.int32)
    positions = offsets + jnp.arange(SEQ, dtype=jnp.int32)[None, :]
    return {
        "x": x,
        "positions": positions,
        "rel_bias_table": 0.5 * jax.random.normal(ks[2], (NUM_BUCKETS, A_HEADS), f32),
        "attn_norm_g": gain(ks[3], (DEPTH, D_MODEL)),
        "w_in": w(ks[4], (DEPTH, D_MODEL, IN_COLS), D_MODEL),
        "sinks": 0.5 * jax.random.normal(ks[5], (DEPTH, A_HEADS), f32),
        "q_norm_g": gain(ks[6], (DEPTH, Q_LORA)),
        "w_q_b": w(ks[7], (DEPTH, Q_LORA, B_HEADS * (NOPE_DIM + ROPE_DIM)), Q_LORA),
        "kv_norm_g": gain(ks[8], (DEPTH, KV_LORA)),
        "w_kv_b": w(ks[9], (DEPTH, KV_LORA, B_HEADS * (NOPE_DIM + V_DIM)), KV_LORA),
        "a_out_norm_g": gain(ks[10], (DEPTH, A_WIDTH)),
        "b_out_norm_g": gain(ks[11], (DEPTH, B_WIDTH)),
        "w_out": w(ks[12], (DEPTH, MIX_WIDTH, D_MODEL), MIX_WIDTH),
        "ffn_norm_g": gain(ks[13], (DEPTH, D_MODEL)),
        "w_up": w(ks[14], (DEPTH, D_MODEL, 2 * D_FF), D_MODEL),
        "conv_w": w(ks[15], (DEPTH, CONV_W, 2 * D_FF), CONV_W),
        "conv_b": 0.01 * jax.random.normal(ks[16], (DEPTH, 2 * D_FF), f32),
        "w_down": w(ks[17], (DEPTH, D_FF, D_MODEL), D_FF),
        "final_norm_g": gain(ks[18], (D_MODEL,)),
    }


def reference(x, positions, rel_bias_table, attn_norm_g, w_in, sinks, q_norm_g, w_q_b,
              kv_norm_g, w_kv_b, a_out_norm_g, b_out_norm_g, w_out, ffn_norm_g, w_up,
              conv_w, conv_b, w_down, final_norm_g):
    b, s, _ = x.shape
    inv_freq = ROPE_THETA ** (-jnp.arange(0, ROPE_DIM, 2, dtype=jnp.float32) / ROPE_DIM)
    ang = positions.astype(jnp.float32)[..., None] * inv_freq
    cuts = np.cumsum(IN_SPLITS)[:-1].tolist()

    for l in range(DEPTH):
        h = rmsnorm(x, attn_norm_g[l])
        proj = h @ w_in[l]
        qa, ka, va, c_q, c_kv, k_pe = jnp.split(proj, cuts, axis=-1)

        qa = qa.reshape(b, s, A_HEADS, A_HEAD_DIM)
        ka = ka.reshape(b, s, A_KV_HEADS, A_HEAD_DIM)
        va = va.reshape(b, s, A_KV_HEADS, A_HEAD_DIM)
        out_a = sliding_window_attention(qa, ka, va, sinks[l], rel_bias_table)

        qb = (rmsnorm(c_q, q_norm_g[l]) @ w_q_b[l]).reshape(b, s, B_HEADS, NOPE_DIM + ROPE_DIM)
        q_nope, q_pe = qb[..., :NOPE_DIM], qb[..., NOPE_DIM:]
        q_pe = rope(q_pe, ang[:, :, None, :])
        kv = (rmsnorm(c_kv, kv_norm_g[l]) @ w_kv_b[l]).reshape(b, s, B_HEADS, NOPE_DIM + V_DIM)
        k_nope, vb = kv[..., :NOPE_DIM], kv[..., NOPE_DIM:]
        k_pe = jnp.broadcast_to(rope(k_pe, ang)[:, :, None, :], (b, s, B_HEADS, ROPE_DIM))
        qm = jnp.concatenate([q_nope, q_pe], axis=-1)
        km = jnp.concatenate([k_nope, k_pe], axis=-1)
        out_b = dense_causal_attention(qm, km, vb)

        mixed = jnp.concatenate([rmsnorm(out_a, a_out_norm_g[l]),
                                 rmsnorm(out_b, b_out_norm_g[l])], axis=-1)
        x = x + mixed @ w_out[l]

        h = rmsnorm(x, ffn_norm_g[l])
        u = causal_dwconv(h @ w_up[l], conv_w[l], conv_b[l])
        gate, val = u[..., :D_FF], u[..., D_FF:]
        x = x + (jax.nn.silu(gate) * val) @ w_down[l]

    return rmsnorm(x, final_norm_g)
```

```cpp
#include <hip/hip_runtime.h>
#include <hip/hip_cooperative_groups.h>
#include <cstdio>
#include <cstdint>
namespace cg = cooperative_groups;

namespace pg8 {
#define PG8_LAS __attribute__((address_space(3)))
typedef unsigned short bf16_t;
typedef short bf16x8 __attribute__((ext_vector_type(8)));
typedef float f32x4 __attribute__((ext_vector_type(4)));
typedef unsigned u32x4 __attribute__((ext_vector_type(4)));
constexpr int BM = 256, BK = 64, HALF = 128, HTB = HALF * BK * 2  , STAGE_BYTES = 8 * HTB, NXCD = 8, WGM = 8;

__host__ __device__ __forceinline__ int lds_byte(int r, int c) { const int st = (r >> 4) * 2 + (c >> 5), rr = r & 15, cc = c & 31, ob = rr * 64 + cc * 2; return st * 1024 + (ob ^ (((ob >> 9) & 1) << 5)); }
__host__ __device__ __forceinline__ void stage_rc(int b, int& R, int& C) { const int st = b / 1024, sb = b % 1024, swz = sb ^ (((sb >> 9) & 1) << 5); R = (st >> 1) * 16 + swz / 64; C = (st & 1) * 32 + (swz % 64) / 2; }
__host__ __device__ __forceinline__ int perm32(int rho) { const int n = rho >> 4, i = rho & 15; return 8 * (i >> 2) + 4 * n + (i & 3); }

struct Unit { int pm, pn; };
struct Gemm { const bf16_t* A; const bf16_t* Bt; int M, N, K; };

struct StaticOrder {
    int nM, nN, nwg, G, c;
    __host__ __device__ void init(int M, int N, int G_, int c_) { nM = M / BM; nN = N / BM; nwg = nM * nN; G = G_; c = c_; }
    __host__ __device__ bool next(int i, Unit& u) const {
        const long L = (long)i * G + c; if (L >= nwg) return false;
        int wgid = (int)L; { const int q = nwg / NXCD, r = nwg % NXCD, xcd = wgid % NXCD, off = wgid / NXCD; wgid = (xcd < r ? xcd * (q + 1) : r * (q + 1) + (xcd - r) * q) + off; }
        const int nig = WGM * nN, gid = wgid / nig, fm = gid * WGM, gsz = (nM - fm) < WGM ? (nM - fm) : WGM;
        u.pm = fm + ((wgid % nig) % gsz); u.pn = (wgid % nig) / gsz; return true;
    }
    __device__ __forceinline__ void a_ready(const Unit&) const {}
    __device__ __forceinline__ void done(const Unit&) const {}
};


typedef unsigned u32x2 __attribute__((ext_vector_type(2)));
__device__ __forceinline__ unsigned cvt_pk_bf16(float lo, float hi) { unsigned r; asm volatile("v_cvt_pk_bf16_f32 %0, %1, %2" : "=v"(r) : "v"(lo), "v"(hi)); return r; }
__device__ __forceinline__ u32x4 pack8(f32x4 a, f32x4 b) { u32x4 w; w.x = cvt_pk_bf16(a[0], a[1]); w.y = cvt_pk_bf16(a[2], a[3]); w.z = cvt_pk_bf16(b[0], b[1]); w.w = cvt_pk_bf16(b[2], b[3]); return w; }
__device__ __forceinline__ u32x2 pack4(f32x4 a) { u32x2 w; w.x = cvt_pk_bf16(a[0], a[1]); w.y = cvt_pk_bf16(a[2], a[3]); return w; }
__device__ __forceinline__ float dot4(f32x4 a) { return (a[0] * a[0] + a[1] * a[1]) + (a[2] * a[2] + a[3] * a[3]); }
__device__ __forceinline__ float red_fq(float s) { s += __shfl_xor(s, 16); s += __shfl_xor(s, 32); return s; }

constexpr float RMS_EPS = 1e-6f;
constexpr float LOG2E = 1.4426950408889634f;
constexpr float C_A = 0.125f * LOG2E;
constexpr float C_B = 0.07216878364870322f * LOG2E;

struct EpiInProj {
    static constexpr bool PERM = true, AFTER_DRAIN = false;
    bf16_t *QA, *KA, *VA, *CQ, *CKV, *KB; float *ssq_q, *ssq_kv; const float* cs;
    __device__ __forceinline__ void operator()(const f32x4 (&acc)[2][2][4][2], const Unit& u, int wr, int wc, int fr, int fq) const {
        const int row0 = u.pm * BM + wr * 64 + fr, cw = wc * 32 + 8 * fq, pn = u.pn;
#pragma unroll
        for (int ai = 0; ai < 2; ++ai)
#pragma unroll
            for (int m = 0; m < 4; ++m) {
                const unsigned row = (unsigned)(row0 + ai * HALF + m * 16);
                if (pn < 2) {
#pragma unroll
                    for (int bj = 0; bj < 2; ++bj) *(u32x4*)(QA + row * 512 + pn * 256 + bj * HALF + cw) = pack8(acc[ai][bj][m][0] * C_A, acc[ai][bj][m][1] * C_A);
                } else if (pn == 2) {
                    *(u32x4*)(KA + row * 128 + cw) = pack8(acc[ai][0][m][0], acc[ai][0][m][1]);
                    *(u32x4*)(VA + row * 128 + cw) = pack8(acc[ai][1][m][0], acc[ai][1][m][1]);
                } else if (pn == 3) {
                    float s = 0.f;
#pragma unroll
                    for (int bj = 0; bj < 2; ++bj) { const f32x4 v0 = acc[ai][bj][m][0], v1 = acc[ai][bj][m][1]; s += dot4(v0) + dot4(v1);
                        *(u32x4*)(CQ + row * 256 + bj * HALF + cw) = pack8(v0, v1); }
                    s = red_fq(s); if (fq == 0) atomicAdd(ssq_q + row, s);
                } else {
                    { const f32x4 v0 = acc[ai][0][m][0], v1 = acc[ai][0][m][1]; float s = dot4(v0) + dot4(v1);
                      *(u32x4*)(CKV + row * 128 + cw) = pack8(v0, v1); s = red_fq(s); if (fq == 0) atomicAdd(ssq_kv + row, s); }
                    if (wc < 2) {
                        const int d = 4 * (4 * wc + fq); const f32x4 x1 = acc[ai][1][m][0], x2 = acc[ai][1][m][1];
                        const f32x4 c = *(const f32x4*)(cs + row * 64 + d), sn = *(const f32x4*)(cs + row * 64 + 32 + d);
                        const u32x2 y1 = pack4(x1 * c - x2 * sn), y2 = pack4(x1 * sn + x2 * c);
#pragma unroll
                        for (int h = 0; h < 4; ++h) { *(u32x2*)(KB + row * 768 + 192 * h + 128 + d) = y1; *(u32x2*)(KB + row * 768 + 192 * h + 160 + d) = y2; }
                    }
                }
                asm volatile("" ::: "memory");
            }
    }
};
struct EpiQB {
    static constexpr bool PERM = true, AFTER_DRAIN = false;
    bf16_t* QB; const float* ssq_q; const float* cs;
    __device__ __forceinline__ void operator()(const f32x4 (&acc)[2][2][4][2], const Unit& u, int wr, int wc, int fr, int fq) const {
        const int row0 = u.pm * BM + wr * 64 + fr, cw = wc * 32 + 8 * fq, pn = u.pn;
#pragma unroll
        for (int ai = 0; ai < 2; ++ai)
#pragma unroll
            for (int m = 0; m < 4; ++m) {
                const unsigned row = (unsigned)(row0 + ai * HALF + m * 16);
                const float rs = __builtin_amdgcn_rsqf(ssq_q[row] * (1.0f / 256.0f) + RMS_EPS) * C_B;
                if (pn < 2) {
#pragma unroll
                    for (int bj = 0; bj < 2; ++bj) *(u32x4*)(QB + row * 768 + 192 * (2 * pn + bj) + cw) = pack8(acc[ai][bj][m][0] * rs, acc[ai][bj][m][1] * rs);
                } else {
                    const int d = 4 * (4 * (wc & 1) + fq);
                    const f32x4 c = *(const f32x4*)(cs + row * 64 + d), sn = *(const f32x4*)(cs + row * 64 + 32 + d);
#pragma unroll
                    for (int bj = 0; bj < 2; ++bj) { const int h = 2 * bj + (wc >> 1); const f32x4 x1 = acc[ai][bj][m][0] * rs, x2 = acc[ai][bj][m][1] * rs;
                        *(u32x2*)(QB + row * 768 + 192 * h + 128 + d) = pack4(x1 * c - x2 * sn); *(u32x2*)(QB + row * 768 + 192 * h + 160 + d) = pack4(x1 * sn + x2 * c); }
                }
                asm volatile("" ::: "memory");
            }
    }
};
struct EpiKVB {
    static constexpr bool PERM = true, AFTER_DRAIN = false;
    bf16_t *KB, *VB; const float* ssq_kv;
    __device__ __forceinline__ void operator()(const f32x4 (&acc)[2][2][4][2], const Unit& u, int wr, int wc, int fr, int fq) const {
        const int row0 = u.pm * BM + wr * 64 + fr, cw = wc * 32 + 8 * fq, h = u.pn;
#pragma unroll
        for (int ai = 0; ai < 2; ++ai)
#pragma unroll
            for (int m = 0; m < 4; ++m) {
                const unsigned row = (unsigned)(row0 + ai * HALF + m * 16);
                const float rs = __builtin_amdgcn_rsqf(ssq_kv[row] * (1.0f / 128.0f) + RMS_EPS);
                *(u32x4*)(KB + row * 768 + 192 * h + cw) = pack8(acc[ai][0][m][0] * rs, acc[ai][0][m][1] * rs);
                *(u32x4*)(VB + row * 512 + 128 * h + cw) = pack8(acc[ai][1][m][0] * rs, acc[ai][1][m][1] * rs);
                asm volatile("" ::: "memory");
            }
    }
};
struct EpiOut {
    static constexpr bool PERM = false, AFTER_DRAIN = false;
    const float* x; float* X1; bf16_t* HB; float* ssq;
    __device__ __forceinline__ void operator()(const f32x4 (&acc)[2][2][4][2], const Unit& u, int wr, int wc, int fr, int fq) const {
        const int row0 = u.pm * BM + wr * 64 + fr, col0 = u.pn * BM + wc * 32 + 4 * fq;
#pragma unroll
        for (int ai = 0; ai < 2; ++ai)
#pragma unroll
            for (int m = 0; m < 4; ++m) {
                const unsigned row = (unsigned)(row0 + ai * HALF + m * 16); const unsigned off = row * 1024u + (unsigned)col0; float s = 0.f;
#pragma unroll
                for (int bj = 0; bj < 2; ++bj)
#pragma unroll
                    for (int n = 0; n < 2; ++n) { const unsigned o = off + (unsigned)(bj * HALF + n * 16); const f32x4 v = *(const f32x4*)(x + o) + acc[ai][bj][m][n];
                        *(f32x4*)(X1 + o) = v; *(u32x2*)(HB + o) = pack4(v); s += dot4(v); }
                s = red_fq(s); if (fq == 0) atomicAdd(ssq + row, s);
                asm volatile("" ::: "memory");
            }
    }
};
struct EpiUp {
    static constexpr bool PERM = true, AFTER_DRAIN = false;
    bf16_t* U; const float* ssq;
    __device__ __forceinline__ void operator()(const f32x4 (&acc)[2][2][4][2], const Unit& u, int wr, int wc, int fr, int fq) const {
        const int row0 = u.pm * BM + wr * 64 + fr, cw = u.pn * BM + wc * 32 + 8 * fq;
#pragma unroll
        for (int ai = 0; ai < 2; ++ai)
#pragma unroll
            for (int m = 0; m < 4; ++m) {
                const unsigned row = (unsigned)(row0 + ai * HALF + m * 16);
                const float rs = __builtin_amdgcn_rsqf(ssq[row] * (1.0f / 1024.0f) + RMS_EPS);
#pragma unroll
                for (int bj = 0; bj < 2; ++bj) *(u32x4*)(U + row * 5632 + bj * HALF + cw) = pack8(acc[ai][bj][m][0] * rs, acc[ai][bj][m][1] * rs);
                asm volatile("" ::: "memory");
            }
    }
};
struct EpiDown {
    static constexpr bool PERM = false, AFTER_DRAIN = false;
    float* X; float* ssq;
    __device__ __forceinline__ void operator()(const f32x4 (&acc)[2][2][4][2], const Unit& u, int wr, int wc, int fr, int fq) const {
        const int row0 = u.pm * BM + wr * 64 + fr, col0 = u.pn * BM + wc * 32 + 4 * fq;
#pragma unroll
        for (int ai = 0; ai < 2; ++ai)
#pragma unroll
            for (int m = 0; m < 4; ++m) {
                const unsigned row = (unsigned)(row0 + ai * HALF + m * 16); const unsigned off = row * 1024u + (unsigned)col0; float s = 0.f;
#pragma unroll
                for (int bj = 0; bj < 2; ++bj)
#pragma unroll
                    for (int n = 0; n < 2; ++n) { const unsigned o = off + (unsigned)(bj * HALF + n * 16); const f32x4 v = *(const f32x4*)(X + o) + acc[ai][bj][m][n];
                        *(f32x4*)(X + o) = v; s += dot4(v); }
                s = red_fq(s); if (fq == 0) atomicAdd(ssq + row, s);
                asm volatile("" ::: "memory");
            }
    }
};

template <class Epi, class Sched, bool ALIGN_EPI = false, bool SP2 = false>
__device__ __forceinline__ void gemm_phase(PG8_LAS unsigned char* lds, const Gemm g, const Sched& S, const Epi& E, const int wid) {
    int lane_v; asm volatile("v_mbcnt_lo_u32_b32 %0, -1, 0\n\tv_mbcnt_hi_u32_b32 %0, -1, %0" : "=v"(lane_v));
    const int lane = lane_v, tid = wid * 64 + lane, wr = wid >> 2, wc = wid & 3, fr = lane & 15, fq = lane >> 4;
    int K_o = g.K; asm volatile("" : "+s"(K_o));
    const int K = K_o, nt = K / BK;
    unsigned voffA[2], voffB[2];
#pragma unroll
    for (int i = 0; i < 2; ++i) { int R, C; stage_rc(tid * 16 + i * 8192, R, C); const int Rb = Epi::PERM ? ((R & ~31) + perm32(R & 31)) : R;
        voffA[i] = (unsigned)(R * K + C) * 2u; voffB[i] = (unsigned)(Rb * K + C) * 2u; }
    const size_t kstep = (size_t)(BK * 2);
    const size_t hstep = (size_t)HALF * K * 2;
    const size_t tstep = 2 * hstep;
    const unsigned ldsw = (unsigned)wid * 1024u;
    const int aoff = lds_byte(wr * 64 + fr, fq * 8), boff = lds_byte(wc * 32 + fr, fq * 8);
#define PG8_SA(b, h) (((b) * 2 + (h)) * HTB)
#define PG8_SB(b, h) ((4 + (b) * 2 + (h)) * HTB)
#define PG8_STAGE(bufoff, gbase, voff) do { _Pragma("unroll") for (int _i = 0; _i < 2; ++_i) \
        __builtin_amdgcn_global_load_lds((const unsigned*)((const char*)(gbase) + (voff)[_i]), (PG8_LAS unsigned*)(lds + (bufoff) + ldsw + _i * 8192), 16, 0, 0); } while (0)
#define PG8_LDA(dst, b, h) do { _Pragma("unroll") for (int m = 0; m < 4; ++m) _Pragma("unroll") for (int k = 0; k < 2; ++k) dst[m][k] = *(const PG8_LAS bf16x8*)(lds + PG8_SA(b, h) + aoff + m * 2048 + k * 1024); } while (0)
#define PG8_LDB(dst, b, h) do { _Pragma("unroll") for (int n = 0; n < 2; ++n) _Pragma("unroll") for (int k = 0; k < 2; ++k) dst[n][k] = *(const PG8_LAS bf16x8*)(lds + PG8_SB(b, h) + boff + n * 2048 + k * 1024); } while (0)
#define PG8_MMA(ai, bj, At, Bt) do { __builtin_amdgcn_s_setprio(1); _Pragma("unroll") for (int m = 0; m < 4; ++m) _Pragma("unroll") for (int n = 0; n < 2; ++n) _Pragma("unroll") for (int k = 0; k < 2; ++k) \
        acc[ai][bj][m][n] = __builtin_amdgcn_mfma_f32_16x16x32_bf16(Bt[n][k], At[m][k], acc[ai][bj][m][n], 0, 0, 0); __builtin_amdgcn_s_setprio(0); } while (0)
#define PG8_WAIT_V(n) asm volatile("s_waitcnt vmcnt(" #n ")" ::: "memory")
#define PG8_WAIT_L(n) asm volatile("s_waitcnt lgkmcnt(" #n ")" ::: "memory")
#define PG8_BAR __builtin_amdgcn_s_barrier()
#define PG8_SCHED __builtin_amdgcn_sched_barrier(0)
    Unit cur, nxt; int ui = 0;
    if (!S.next(0, cur)) return;
    f32x4 acc[2][2][4][2];
#pragma unroll
    for (int a = 0; a < 2; ++a)
#pragma unroll
        for (int b = 0; b < 2; ++b)
#pragma unroll
            for (int m = 0; m < 4; ++m)
#pragma unroll
                for (int n = 0; n < 2; ++n) acc[a][b][m][n] = (f32x4){0.f, 0.f, 0.f, 0.f};
    bf16x8 At[4][2], B0[2][2], B1[2][2];
    const char* cA = (const char*)g.A + (size_t)cur.pm * tstep; const char* cB = (const char*)g.Bt + (size_t)cur.pn * tstep;
    S.a_ready(cur);
    if constexpr (SP2) {
        PG8_STAGE(PG8_SB(0, 0), cB, voffB); PG8_STAGE(PG8_SB(0, 1), cB + hstep, voffB); PG8_STAGE(PG8_SA(0, 0), cA, voffA); PG8_STAGE(PG8_SA(0, 1), cA + hstep, voffA);
        if (wr == 1) PG8_BAR;
        PG8_WAIT_V(2); PG8_BAR;
        PG8_STAGE(PG8_SB(1, 0), cB + kstep, voffB); PG8_STAGE(PG8_SA(1, 0), cA + kstep, voffA); PG8_STAGE(PG8_SB(1, 1), cB + hstep + kstep, voffB);
        PG8_WAIT_V(6); PG8_BAR;
    } else {
        PG8_STAGE(PG8_SB(0, 0), cB, voffB); PG8_STAGE(PG8_SA(0, 0), cA, voffA); PG8_STAGE(PG8_SB(0, 1), cB + hstep, voffB); PG8_STAGE(PG8_SA(0, 1), cA + hstep, voffA);
        if (wr == 1) PG8_BAR;
        PG8_WAIT_V(4); PG8_BAR;
        PG8_STAGE(PG8_SB(1, 0), cB + kstep, voffB); PG8_STAGE(PG8_SA(1, 0), cA + kstep, voffA); PG8_STAGE(PG8_SB(1, 1), cB + hstep + kstep, voffB);
        PG8_WAIT_V(6); PG8_BAR;
    }
    for (;;) {
        const bool has_next = S.next(ui + 1, nxt);
        const char* nA = has_next ? (const char*)g.A + (size_t)nxt.pm * tstep : cA; const char* nB = has_next ? (const char*)g.Bt + (size_t)nxt.pn * tstep : cB;
        for (int t = 0; t < nt; t += 2) {
            const bool last = (t == nt - 2);
            const char* a1 = cA + (size_t)(t + 1) * kstep;
            const char* a2 = last ? nA : cA + (size_t)(t + 2) * kstep; const char* b2 = last ? nB : cB + (size_t)(t + 2) * kstep;
            const char* a3 = a2 + kstep; const char* b3 = b2 + kstep;
            if (last && has_next) S.a_ready(nxt);
            if constexpr (SP2) {
            PG8_LDB(B0, 0, 0); PG8_LDB(B1, 0, 1); PG8_SCHED; PG8_LDA(At, 0, 0); PG8_STAGE(PG8_SA(1, 1), a1 + hstep, voffA);
            PG8_WAIT_V(8); PG8_WAIT_L(0); PG8_BAR; PG8_MMA(0, 0, At, B0); PG8_MMA(0, 1, At, B1); PG8_BAR; PG8_SCHED;
            PG8_LDA(At, 0, 1); PG8_STAGE(PG8_SB(0, 0), b2, voffB); PG8_STAGE(PG8_SB(0, 1), b2 + hstep, voffB); PG8_STAGE(PG8_SA(0, 0), a2, voffA);
            PG8_WAIT_V(8); PG8_WAIT_L(0); PG8_BAR; PG8_MMA(1, 0, At, B0); PG8_MMA(1, 1, At, B1); PG8_BAR; PG8_SCHED;
            PG8_LDB(B0, 1, 0); PG8_LDB(B1, 1, 1); PG8_SCHED; PG8_LDA(At, 1, 0); PG8_STAGE(PG8_SA(0, 1), a2 + hstep, voffA);
            PG8_WAIT_V(8); PG8_WAIT_L(0); PG8_BAR; PG8_MMA(0, 0, At, B0); PG8_MMA(0, 1, At, B1); PG8_BAR; PG8_SCHED;
            PG8_LDA(At, 1, 1); PG8_STAGE(PG8_SB(1, 0), b3, voffB); PG8_STAGE(PG8_SB(1, 1), b3 + hstep, voffB); PG8_STAGE(PG8_SA(1, 0), a3, voffA);
            PG8_WAIT_V(8); PG8_WAIT_L(0); PG8_BAR; PG8_MMA(1, 0, At, B0); PG8_MMA(1, 1, At, B1); PG8_BAR; PG8_SCHED;
            } else {
            PG8_LDB(B0, 0, 0); PG8_SCHED; PG8_LDA(At, 0, 0); PG8_STAGE(PG8_SA(1, 1), a1 + hstep, voffA);
            PG8_WAIT_L(8); PG8_BAR; PG8_WAIT_L(0); PG8_MMA(0, 0, At, B0); PG8_BAR; PG8_SCHED;
            PG8_LDB(B1, 0, 1); PG8_STAGE(PG8_SB(0, 0), b2, voffB);
            PG8_BAR; PG8_WAIT_L(0); PG8_MMA(0, 1, At, B1); PG8_BAR;
            PG8_LDA(At, 0, 1); PG8_STAGE(PG8_SA(0, 0), a2, voffA);
            PG8_BAR; PG8_WAIT_L(0); PG8_MMA(1, 0, At, B0); PG8_BAR; PG8_SCHED;
            PG8_STAGE(PG8_SB(0, 1), b2 + hstep, voffB);
            PG8_WAIT_V(6); PG8_BAR; PG8_MMA(1, 1, At, B1); PG8_BAR;
            PG8_LDB(B0, 1, 0); PG8_SCHED; PG8_LDA(At, 1, 0); PG8_STAGE(PG8_SA(0, 1), a2 + hstep, voffA);
            PG8_WAIT_L(8); PG8_BAR; PG8_WAIT_L(0); PG8_MMA(0, 0, At, B0); PG8_BAR; PG8_SCHED;
            PG8_LDB(B1, 1, 1); PG8_STAGE(PG8_SB(1, 0), b3, voffB);
            PG8_BAR; PG8_WAIT_L(0); PG8_MMA(0, 1, At, B1); PG8_BAR;
            PG8_LDA(At, 1, 1); PG8_STAGE(PG8_SA(1, 0), a3, voffA);
            PG8_BAR; PG8_WAIT_L(0); PG8_MMA(1, 0, At, B0); PG8_BAR; PG8_SCHED;
            PG8_STAGE(PG8_SB(1, 1), b3 + hstep, voffB);
            PG8_WAIT_V(6); PG8_BAR; PG8_MMA(1, 1, At, B1); PG8_BAR;
            }
        }
        if constexpr (ALIGN_EPI) { if (wr == 0) PG8_BAR; }
        if constexpr (!Epi::AFTER_DRAIN) { E(acc, cur, wr, wc, fr, fq); S.done(cur); }
        if (!has_next) break;
#pragma unroll
        for (int a = 0; a < 2; ++a)
#pragma unroll
            for (int b = 0; b < 2; ++b)
#pragma unroll
                for (int m = 0; m < 4; ++m)
#pragma unroll
                    for (int n = 0; n < 2; ++n) acc[a][b][m][n] = (f32x4){0.f, 0.f, 0.f, 0.f};
        cur = nxt; cA = nA; cB = nB; ++ui;
        if constexpr (ALIGN_EPI) { if (wr == 1) PG8_BAR; }
    }
    PG8_WAIT_V(0);
    if constexpr (!ALIGN_EPI) { if (wr == 0) PG8_BAR; }
    PG8_BAR;
    if constexpr (Epi::AFTER_DRAIN) { E.fused(acc, cur, wr, wc, fr, fq, lds, wid, lane); S.done(cur); }
#undef PG8_SA
#undef PG8_SB
#undef PG8_STAGE
#undef PG8_LDA
#undef PG8_LDB
#undef PG8_MMA
#undef PG8_WAIT_V
#undef PG8_WAIT_L
#undef PG8_BAR
#undef PG8_SCHED
}
}

namespace att {
typedef unsigned short bf16_t;
typedef short bf16x8 __attribute__((ext_vector_type(8)));
typedef short s16x4 __attribute__((ext_vector_type(4)));
typedef float f32x16 __attribute__((ext_vector_type(16)));
typedef float f32x4 __attribute__((ext_vector_type(4)));
typedef unsigned u32x4 __attribute__((ext_vector_type(4)));
constexpr int NW = 8, QBLK = 32, KVBLK = 64, QB = NW * QBLK;
constexpr float THRL = 8.f;
#define SBAR() __builtin_amdgcn_sched_barrier(0)
__device__ __forceinline__ int crow(int r, int hi) { return (r & 3) + 8 * (r >> 2) + 4 * hi; }
__device__ __forceinline__ unsigned cvtpk(float lo, float hi) { unsigned r; asm volatile("v_cvt_pk_bf16_f32 %0, %1, %2" : "=v"(r) : "v"(lo), "v"(hi)); return r; }
__device__ __forceinline__ int v_rd_base(int lane) { return ((lane & 3) << 3) | (((lane >> 2) & 3) << 6) | (((lane >> 4) & 1) << 5) | (((lane >> 5) & 1) << 8); }
__device__ __forceinline__ void mask_tile(f32x16& p0, f32x16& p1, int dq, unsigned W) {
    const float NEG = -__builtin_inff();
#pragma unroll
    for (int r = 0; r < 16; ++r) { const int c = (r & 3) + 8 * (r >> 2);
        if ((unsigned)(dq - c) >= W) p0[r] = NEG;
        if ((unsigned)(dq - c - 32) >= W) p1[r] = NEG; }
}
__device__ __forceinline__ void bias_tile(f32x16& p0, f32x16& p1, int dq, const float* tb) {
#pragma unroll
    for (int r = 0; r < 16; ++r) { const int c = (r & 3) + 8 * (r >> 2);
        p0[r] += tb[(dq - c) & 255];
        p1[r] += tb[(dq - c - 32) & 255]; }
}
__device__ __forceinline__ void partialSM(f32x16& p0, f32x16& p1, float& m_reg, float& mn, float& alpha) {
    float pmax = p0[0];
#pragma unroll
    for (int r = 1; r < 16; ++r) pmax = fmaxf(pmax, p0[r]);
#pragma unroll
    for (int r = 0; r < 16; ++r) pmax = fmaxf(pmax, p1[r]);
    { auto rr = __builtin_amdgcn_permlane32_swap(__float_as_uint(pmax), __float_as_uint(pmax), false, false);
      pmax = fmaxf(__uint_as_float(rr[0]), __uint_as_float(rr[1])); }
    if (__builtin_expect(__all((pmax - m_reg) <= THRL), 1)) { mn = m_reg; alpha = 1.f; }
    else { mn = fmaxf(m_reg, pmax); alpha = __builtin_amdgcn_exp2f(m_reg - mn); m_reg = mn; }
#pragma unroll
    for (int r = 0; r < 16; ++r) p0[r] -= mn;
#pragma unroll
    for (int r = 0; r < 16; ++r) p1[r] -= mn;
#pragma unroll
    for (int r = 0; r < 16; ++r) p0[r] = __builtin_amdgcn_exp2f(p0[r]);
}
__device__ __forceinline__ void finishSM(f32x16& p0, f32x16& p1, float alpha, float& l_reg, bf16x8& pa0, bf16x8& pa1, bf16x8& pa2, bf16x8& pa3) {
#pragma unroll
    for (int r = 0; r < 16; ++r) p1[r] = __builtin_amdgcn_exp2f(p1[r]);
    float ps = 0;
#pragma unroll
    for (int r = 0; r < 16; ++r) ps += p0[r];
#pragma unroll
    for (int r = 0; r < 16; ++r) ps += p1[r];
    { auto rr = __builtin_amdgcn_permlane32_swap(__float_as_uint(ps), __float_as_uint(ps), false, false);
      ps = __uint_as_float(rr[0]) + __uint_as_float(rr[1]); }
    l_reg = l_reg * alpha + ps;
#define PK4(P, B_, OUT) do { unsigned a0 = cvtpk(P[B_+0], P[B_+1]), a1 = cvtpk(P[B_+2], P[B_+3]);                          \
        unsigned b0 = cvtpk(P[B_+4], P[B_+5]), b1 = cvtpk(P[B_+6], P[B_+7]);                                             \
        auto r0 = __builtin_amdgcn_permlane32_swap(a0, b0, false, false); auto r1 = __builtin_amdgcn_permlane32_swap(a1, b1, false, false); \
        u32x4 w = {r0[0], r1[0], r0[1], r1[1]}; OUT = *reinterpret_cast<bf16x8*>(&w); } while (0)
    PK4(p0, 0, pa0); PK4(p0, 8, pa1); PK4(p1, 0, pa2); PK4(p1, 8, pa3);
#undef PK4
}

template <int DQK, int DV, int LDQ, int LDK, int LDV, int LDO, bool SWA, int NQR>
struct Body {
    static constexpr int KROW = DQK * 2, SHM_K = KVBLK * KROW, SHM_V = KVBLK * DV * 2, NCB = DV / 32, KS_STR = 2 * NCB * 512, HF_STR = NCB * 512;
    static constexpr int ND = DQK / 16, NKP = (DQK == 192) ? 3 : 1, NVP = DV / 64, NDV = DV / 32;
    static constexpr int OFF_V = 0, OFF_K = 2 * SHM_V, OFF_WS = OFF_K + 2 * SHM_K, OFF_TBL = OFF_WS + NW * 64 * 4, OFF_QL = OFF_TBL + 2048, NQL_LDS = DQK / 16 - NQR, QL_WAVE = QBLK * NQL_LDS * 32, LDS_BYTES = OFF_QL + NW * QL_WAVE;
    static constexpr bool SK = SWA;
    static_assert((DQK == 192 || DQK == 64) && (DV == 128 || DV == 64), "geometry");
    struct Ref { const bf16_t* Q; const bf16_t* K; const bf16_t* V; bf16_t* O; int P0; const float* bias; float sink; };
    struct Seam { bf16x8 qr[NQR]; bf16x8 st_k[NKP]; bf16x8 st_v[NVP]; };

    static __device__ __forceinline__ int kswz(int row, int colB) { return row * KROW + (colB ^ ((row & 7) << 4)); }
    static __device__ __forceinline__ int v_st(int k, int c) { const int kk = (k & ~0xC) | ((k & 4) << 1) | ((k & 8) >> 1); return ((kk >> 3) * NCB + (c >> 5)) * 512 + ((kk & 7) * 32 + (c & 31)) * 2; }
    static __device__ __forceinline__ void kpiece(int tid, int p, int& row, int& col) {
        if (DQK == 192) { if (p < 2) { row = (tid >> 4) + 32 * p; col = (tid & 15) * 8; } else { row = tid >> 3; col = 128 + (tid & 7) * 8; } }
        else { row = tid >> 3; col = (tid & 7) * 8; }
    }
    static __device__ __forceinline__ void vpiece(int tid, int p, int& row, int& col) {
        if (DV == 128) { row = (tid >> 4) + 32 * p; col = (tid & 15) * 8; } else { row = tid >> 3; col = (tid & 7) * 8; }
    }
    static __device__ __forceinline__ int swa_jlo(int P0, int W) { const int lowk = P0 - W + 1; return lowk > 0 ? lowk / KVBLK : 0; }

    template <int KB>
    static __device__ __forceinline__ void qkt(f32x16& p0, f32x16& p1, const char* K_lds, int r32, int hi, const bf16x8* qr, const char* qlw, bool act) {
        if (SK && !act) { const float NEG = -__builtin_inff();
#pragma unroll
            for (int r = 0; r < 16; ++r) { p0[r] = NEG; p1[r] = NEG; } return; }
        p0 = f32x16{}; p1 = f32x16{};
        const char* kb[4];
#pragma unroll
        for (int dd = 0; dd < 4; ++dd) kb[dd] = K_lds + KB * SHM_K + kswz(r32, (dd * 16 + hi * 8) * 2);
#pragma unroll
        for (int d0 = 0; d0 < ND; ++d0) { const char* a = kb[d0 & 3] + (d0 >> 2) * 128;
            if (ND > 8 && (d0 & 3) == 0 && d0 > 0) SBAR();
            bf16x8 b0 = *reinterpret_cast<const bf16x8*>(a);
            bf16x8 b1 = *reinterpret_cast<const bf16x8*>(a + 32 * KROW);
            bf16x8 qf;
            if (d0 < NQR) qf = qr[d0 < NQR ? d0 : 0]; else qf = *reinterpret_cast<const bf16x8*>(qlw + (((2 * (d0 - NQR) + hi) * 16) ^ ((r32 & 7) << 4)));
            p0 = __builtin_amdgcn_mfma_f32_32x32x16_bf16(b0, qf, p0, 0, 0, 0);
            p1 = __builtin_amdgcn_mfma_f32_32x32x16_bf16(b1, qf, p1, 0, 0, 0); }
    }
    template <int VB>
    static __device__ __forceinline__ void pv_tile(f32x16* o, int vb0, bf16x8 pa0, bf16x8 pa1, bf16x8 pa2, bf16x8 pa3, bool act) {
        if (SK && !act) return;
#define TRRD(dst, off) asm volatile("ds_read_b64_tr_b16 %0, %1 offset:%2" : "=&v"(dst) : "v"(vb0), "i"(off) : "memory")
#define PV_D0(d0) do { s16x4 l0, l1, l2, l3, h0, h1, h2, h3; constexpr int b_ = VB * SHM_V + (d0) * 512; \
        TRRD(l0, b_); TRRD(h0, b_ + HF_STR); TRRD(l1, b_ + KS_STR); TRRD(h1, b_ + KS_STR + HF_STR); TRRD(l2, b_ + 2 * KS_STR); TRRD(h2, b_ + 2 * KS_STR + HF_STR); TRRD(l3, b_ + 3 * KS_STR); TRRD(h3, b_ + 3 * KS_STR + HF_STR); \
        asm volatile("s_waitcnt lgkmcnt(0)" ::: "memory"); SBAR(); \
        o[d0] = __builtin_amdgcn_mfma_f32_32x32x16_bf16(pa0, (bf16x8){l0[0], l0[1], l0[2], l0[3], h0[0], h0[1], h0[2], h0[3]}, o[d0], 0, 0, 0);   \
        o[d0] = __builtin_amdgcn_mfma_f32_32x32x16_bf16(pa1, (bf16x8){l1[0], l1[1], l1[2], l1[3], h1[0], h1[1], h1[2], h1[3]}, o[d0], 0, 0, 0);   \
        o[d0] = __builtin_amdgcn_mfma_f32_32x32x16_bf16(pa2, (bf16x8){l2[0], l2[1], l2[2], l2[3], h2[0], h2[1], h2[2], h2[3]}, o[d0], 0, 0, 0);   \
        o[d0] = __builtin_amdgcn_mfma_f32_32x32x16_bf16(pa3, (bf16x8){l3[0], l3[1], l3[2], l3[3], h3[0], h3[1], h3[2], h3[3]}, o[d0], 0, 0, 0); } while (0)
        PV_D0(0); PV_D0(1); if constexpr (NDV == 4) { PV_D0(2); PV_D0(3); }
#undef PV_D0
#undef TRRD
    }

#define VMW() asm volatile("s_waitcnt vmcnt(0)" ::: "memory")
#define VMWN(n) asm volatile("s_waitcnt vmcnt(%0)" :: "i"(n) : "memory")
#define SLOAD_H(Kp, Vp, k0) do { \
        _Pragma("unroll") for (int p_ = 0; p_ < NVP; ++p_) { int rr_, cc_; vpiece(tid, p_, rr_, cc_); S.st_v[p_] = *reinterpret_cast<const bf16x8*>((Vp) + (unsigned)(((k0) + rr_) * LDV + cc_)); } \
        _Pragma("unroll") for (int p_ = 0; p_ < NKP; ++p_) { int rr_, cc_; kpiece(tid, p_, rr_, cc_); S.st_k[p_] = *reinterpret_cast<const bf16x8*>((Kp) + (unsigned)(((k0) + rr_) * LDK + cc_)); } } while (0)
#define SWRITE_HK(bf) do { _Pragma("unroll") for (int p_ = 0; p_ < NKP; ++p_) { int rr_, cc_; kpiece(tid, p_, rr_, cc_); *(bf16x8*)(K_lds + (bf) * SHM_K + kswz(rr_, cc_ * 2)) = S.st_k[p_]; } } while (0)
#define SWRITE_HV(bf) do { _Pragma("unroll") for (int p_ = 0; p_ < NVP; ++p_) { int rr_, cc_; vpiece(tid, p_, rr_, cc_); *(bf16x8*)(V_lds + (bf) * SHM_V + v_st(rr_, cc_)) = S.st_v[p_]; } } while (0)
#define SWRITE_H(bf) do { SWRITE_HV(bf); SWRITE_HK(bf); } while (0)
#define QLOAD(ref) do { _Pragma("unroll") for (int d0 = 0; d0 < NQR; ++d0) S.qr[d0] = *reinterpret_cast<const bf16x8*>((ref).Q + (size_t)(wid * QBLK + r32) * LDQ + d0 * 16 + hi * 8); } while (0)
#define QLDS_FILL(ref) do { if constexpr (NQL_LDS > 0) { bf16x8 t_[NQL_LDS]; \
        _Pragma("unroll") for (int e_ = 0; e_ < NQL_LDS; ++e_) t_[e_] = *reinterpret_cast<const bf16x8*>((ref).Q + (size_t)(wid * QBLK + r32) * LDQ + (NQR + e_) * 16 + hi * 8); \
        _Pragma("unroll") for (int e_ = 0; e_ < NQL_LDS; ++e_) *(bf16x8*)(lds + OFF_QL + wid * QL_WAVE + r32 * (NQL_LDS * 32) + (((2 * e_ + hi) * 16) ^ ((r32 & 7) << 4))) = t_[e_]; \
        asm volatile("s_waitcnt lgkmcnt(0)" ::: "memory"); } } while (0)

    static __device__ __forceinline__ void block(const Ref& cur, int skv, int W, char* lds, const int wid) {
        int lane_v; asm volatile("v_mbcnt_lo_u32_b32 %0, -1, 0\n\tv_mbcnt_hi_u32_b32 %0, -1, %0" : "=v"(lane_v));
        const int lane = lane_v, tid = wid * 64 + lane, r32 = lane & 31, hi = lane >> 5;
        Seam S;
        const int j_lo = swa_jlo(cur.P0, W);
        int j_hi = (cur.P0 + QB - 1) / KVBLK + 1; if (j_hi > skv / KVBLK) j_hi = skv / KVBLK;
        const int NT = j_hi - j_lo;
        const int qlo = cur.P0 + wid * QBLK, qm = qlo + r32 - 4 * hi;
        char* V_lds = lds + OFF_V; char* K_lds = lds + OFF_K;
        float* ws = (float*)(lds + OFF_WS) + wid * 64; float* li_l = ws, * al_l = ws + 32;
        const float* tb = (const float*)(lds + OFF_TBL);
        const char* qlw = lds + OFF_QL + wid * QL_WAVE + r32 * (NQL_LDS * 32);
        float m_reg = SWA ? cur.sink : -1e30f, l_reg = SWA ? 1.f : 0.f; f32x16 o[NDV];
#pragma unroll
        for (int d_ = 0; d_ < NDV; ++d_) o[d_] = f32x16{};
        const int vb0 = (int)(uintptr_t)V_lds + v_rd_base(lane);
        const bf16_t* Kh = cur.K; const bf16_t* Vh = cur.V;
#define KBASE(t) ((j_lo + (t)) * KVBLK)
#define ACT(t) (KBASE(t) <= qlo + QBLK - 1 && KBASE(t) + KVBLK - 1 >= qlo - W + 1)
        QLOAD(cur); QLDS_FILL(cur);
        if (SWA) { if (tid < 256) ((float*)(lds + OFF_TBL))[tid] = tid < 128 ? cur.bias[tid] : 0.f; }
        SLOAD_H(Kh, Vh, KBASE(0)); VMW(); SWRITE_H(0);
        __syncthreads();
        for (int t = 0; t < NT; ++t) {
            const int bo = t & 1;
            f32x16 p0, p1; float mn, alpha; bf16x8 pa0, pa1, pa2, pa3;
            const bool act = ACT(t);
            if (t + 1 < NT) { SLOAD_H(Kh, Vh, KBASE(t + 1)); }
            SBAR();
            if (bo == 0) qkt<0>(p0, p1, K_lds, r32, hi, S.qr, qlw, act); else qkt<1>(p0, p1, K_lds, r32, hi, S.qr, qlw, act);
            { const int kb_ = KBASE(t);
              if (!SK || act) { if (SWA) bias_tile(p0, p1, qm - kb_, tb);
                  if (kb_ + KVBLK - 1 > qlo || kb_ <= qlo + QBLK - 1 - W) mask_tile(p0, p1, qm - kb_, (unsigned)W); } }
            partialSM(p0, p1, m_reg, mn, alpha);
            if (__any(alpha < 1.f)) { if (hi == 0) al_l[r32] = alpha; asm volatile("s_waitcnt lgkmcnt(0)" ::: "memory");
#pragma unroll
                for (int d_ = 0; d_ < NDV; ++d_)
#pragma unroll
                    for (int r = 0; r < 16; ++r) o[d_][r] *= al_l[crow(r, hi)]; }
            finishSM(p0, p1, alpha, l_reg, pa0, pa1, pa2, pa3); SBAR();
            if (bo == 0) pv_tile<0>(o, vb0, pa0, pa1, pa2, pa3, act); else pv_tile<1>(o, vb0, pa0, pa1, pa2, pa3, act);
            SBAR();
            if (t + 1 < NT) { VMW(); if (bo == 0) { SWRITE_H(1); } else { SWRITE_H(0); } }
            __syncthreads();
        }
        if (hi == 0) li_l[r32] = l_reg; asm volatile("s_waitcnt lgkmcnt(0)" ::: "memory");
        float rli[16];
#pragma unroll
        for (int r = 0; r < 16; ++r) rli[r] = __builtin_amdgcn_rcpf(li_l[crow(r, hi)]);
        bf16_t* Ow = cur.O + (size_t)(wid * QBLK) * LDO;
#pragma unroll
        for (int r = 0; r < 16; ++r) { const int orow = crow(r, hi);
#pragma unroll
            for (int d0 = 0; d0 < NDV; ++d0) { const float v = o[d0][r] * rli[r];
                const float vn = __shfl_xor(v, 1);
                if ((r32 & 1) == 0) *(unsigned*)(Ow + (size_t)orow * LDO + d0 * 32 + r32) = cvtpk(v, vn); } }
        __syncthreads();
#undef KBASE
#undef ACT
    }
#undef VMW
#undef VMWN
#undef SLOAD_H
#undef SWRITE_HK
#undef SWRITE_HV
#undef SWRITE_H
#undef QLOAD
#undef QLDS_FILL
};
#undef SBAR
}

constexpr int NWAVES = 8;
constexpr int BATCH = 2, SEQ = 16384, DM = 1024, MTOK = BATCH * SEQ;
constexpr int IN_COLS = 1216, IN_N = 1280, QB_N = 768, KVB_N = 1024, QL = 256, KVL = 128, DFF = 2816, UP_N = 5632;
constexpr float LOG2E_F = 1.4426950408889634f;
#ifndef MLA_NQR
#define MLA_NQR 8
#endif

constexpr size_t MiB = 1u << 20;
constexpr size_t WS_CTL = 0, CTL_ZERO_BYTES = 1 * MiB;
constexpr size_t WS_BIAS = 1 * MiB;
constexpr size_t WS_WIN = 2 * MiB, WS_WQB = 5 * MiB, WS_WKVB = 6 * MiB, WS_WOUT = 7 * MiB, WS_WUP = 9 * MiB, WS_WDOWN = 20 * MiB;
constexpr size_t WS_CS = 26 * MiB;
constexpr size_t WS_H0 = 34 * MiB;
constexpr size_t WS_QA = 98 * MiB, WS_KA = 130 * MiB, WS_VA = 138 * MiB, WS_CQ = 146 * MiB, WS_CKV = 162 * MiB, WS_QB = 170 * MiB, WS_KB = 218 * MiB, WS_VB = 266 * MiB, WS_MIX = 298 * MiB;
constexpr size_t WS_ACT = 98 * MiB;
constexpr size_t WS_U = 274 * MiB;
constexpr size_t WS_END = 450 * MiB;

constexpr int RING_BYTES = 131072, LDS_BYTES = 147456;

#define GAS __attribute__((address_space(1)))
#define LAS __attribute__((address_space(3)))
typedef unsigned short bf16;
typedef unsigned v4u __attribute__((ext_vector_type(4)));
typedef unsigned v2u __attribute__((ext_vector_type(2)));
typedef float f32x4 __attribute__((ext_vector_type(4)));
#define LDS_WAIT() asm volatile("s_waitcnt lgkmcnt(0)" ::: "memory")
__device__ __forceinline__ unsigned f2bf(float f) { unsigned u = __builtin_bit_cast(unsigned, f); return (u + 0x7fffu + ((u >> 16) & 1u)) >> 16; }
__device__ __forceinline__ unsigned pk2(float lo, float hi) { return f2bf(lo) | (f2bf(hi) << 16); }
__device__ __forceinline__ float bf2f(unsigned short b) { return __builtin_bit_cast(float, (unsigned)b << 16); }
__device__ __forceinline__ float wave_sum(float v) {
#pragma unroll
    for (int o = 1; o < 64; o <<= 1) v += __shfl_xor(v, o);
    return v;
}

typedef GAS unsigned gu32;
#define RLX_AGENT __ATOMIC_RELAXED, __HIP_MEMORY_SCOPE_AGENT
constexpr size_t WS_BAR = 768 * 1024;
constexpr int MISC_OFF = 147456 - 64;
#define XB_TMO      128
#define XB_XCNT(j)  (256  + 64 * (j))
#define XB_XSUB(j)  (1280 + 64 * (j))
#define XB_XGEN(j)  (2304 + 64 * (j))
#define XB_TOP      3328
#define XB_TOPGEN   3392
#define XCD_BAR_WORDS 3456
#define XB_SPIN_CAP (1u << 18)

__device__ __forceinline__ unsigned xb_ld(unsigned* p)              { return __hip_atomic_load(p, __ATOMIC_RELAXED, __HIP_MEMORY_SCOPE_AGENT); }
__device__ __forceinline__ unsigned xb_add(unsigned* p, unsigned v) { return __hip_atomic_fetch_add(p, v, __ATOMIC_RELAXED, __HIP_MEMORY_SCOPE_AGENT); }
__device__ __forceinline__ unsigned xb_xcc_id() { return (unsigned)__builtin_amdgcn_s_getreg((3 << 11) | 20) & 0xFu; }
#define XB_SPIN(cond, bar) do { unsigned _sp = 0; while (cond) { __builtin_amdgcn_s_sleep(1); \
    if ((++_sp & 255u) == 0u) { if (xb_ld(&(bar)[XB_TMO])) break; if (_sp > XB_SPIN_CAP) { atomicAdd(&(bar)[XB_TMO], 1u); break; } } } } while (0)

struct XcdBarrier {
    unsigned* bar; unsigned x;
    volatile LAS unsigned* st;
};

__device__ __forceinline__ XcdBarrier xcd_barrier_post(unsigned* bar, volatile LAS unsigned* st, bool leader) {
    XcdBarrier b; b.bar = bar; b.x = xb_xcc_id(); b.st = st;
    if (leader) (void)xb_add(&bar[XB_XCNT(b.x)], 1u);
    return b;
}
__device__ __forceinline__ void xcd_barrier_complete(unsigned* bar, unsigned x, unsigned& nloc, unsigned& nx) {
    const unsigned G = gridDim.x * gridDim.y * gridDim.z;
    unsigned sum, cnt, mine, sp = 0u;
    for (;;) {
        sum = 0u; cnt = 0u; mine = 0u;
#pragma unroll
        for (unsigned j = 0; j < 16; ++j) { const unsigned c = xb_ld(&bar[XB_XCNT(j)]); sum += c; cnt += (c > 0u) ? 1u : 0u; mine = (j == x) ? c : mine; }
        if (sum == G) break;
        __builtin_amdgcn_s_sleep(1);
        if ((++sp & 255u) == 0u) { if (xb_ld(&bar[XB_TMO])) break; if (sp > XB_SPIN_CAP) { atomicAdd(&bar[XB_TMO], 1u); break; } }
    }
    nloc = mine > 0u ? mine : 1u; nx = cnt > 0u ? cnt : 1u;
}

__device__ __forceinline__ void xcd_barrier(const XcdBarrier& b, bool leader) {
    asm volatile("s_waitcnt vmcnt(0)" ::: "memory");
    __syncthreads();
    if (leader) {
        unsigned* bar = b.bar;
        __builtin_amdgcn_s_waitcnt(0);
        unsigned nloc = b.st[0], nx = b.st[1];
        if (nloc == 0u) { xcd_barrier_complete(bar, b.x, nloc, nx); b.st[0] = nloc; b.st[1] = nx; }
        const unsigned old = xb_add(&bar[XB_XSUB(b.x)], 1u);
        const unsigned gen = old / nloc;
        if (old + 1u == (gen + 1u) * nloc) {
            __builtin_amdgcn_fence(__ATOMIC_RELEASE, "agent");
            asm volatile("s_waitcnt vmcnt(0)" ::: "memory");
            const unsigned og = xb_add(&bar[XB_TOP], 1u);
            const unsigned tg = og / nx;
            if (og + 1u == (tg + 1u) * nx) xb_add(&bar[XB_TOPGEN], 1u);
            else XB_SPIN(xb_ld(&bar[XB_TOPGEN]) == tg, bar);
            __builtin_amdgcn_fence(__ATOMIC_ACQUIRE, "agent");
            xb_add(&bar[XB_XGEN(b.x)], 1u);
            asm volatile("s_waitcnt vmcnt(0)" ::: "memory");
        } else {
            XB_SPIN(xb_ld(&bar[XB_XGEN(b.x)]) == gen, bar);
            __builtin_amdgcn_fence(__ATOMIC_ACQUIRE, "agent");
            asm volatile("s_waitcnt vmcnt(0)" ::: "memory");
        }
    }
    __syncthreads();
}

struct Args { const float* in[19]; const int* pos; float* out; unsigned char* ws; };

__device__ __forceinline__ int dst_row(int mode, int n) {
    if (mode == 1) {
        if (n < 1152) return n; const int e = n - 1152, d = e & 31, hf = e >> 5; return 1152 + 8 * (d >> 2) + 4 * hf + (d & 3);
    } else if (mode == 2) {
        const int h = n / 192, e = n - h * 192; if (e < 128) return 128 * h + e; const int ee = e - 128, d = ee & 31, hf = ee >> 5; return 512 + 64 * h + 8 * (d >> 2) + 4 * hf + (d & 3);
    } else if (mode == 3) {
        if (n < DFF) return 256 * (n >> 7) + (n & 127); const int v = n - DFF; return 256 * (v >> 7) + 128 + (v & 127);
    }
    return n;
}
__device__ __forceinline__ void p0_transpose_item(const float* W, int K, int N, const float* gk, bf16* WT, int mode, LAS float* scr, int item, int lane) {
    const int nblk = N / 32, kb = item / nblk, nb = item % nblk, k0 = 64 * kb, n0 = 32 * nb;
#pragma unroll 8
    for (int i = 0; i < 32; ++i) { const int kk = 2 * i + (lane >> 5); float w = W[(size_t)(k0 + kk) * N + n0 + (lane & 31)]; if (gk) w *= gk[k0 + kk]; scr[kk * 33 + (lane & 31)] = w; }
    LDS_WAIT(); asm volatile("" ::: "memory");
    const int c = lane & 7;
#pragma unroll
    for (int j = 0; j < 4; ++j) { const int n = (lane >> 3) + 8 * j; const LAS float* s = scr + (8 * c) * 33 + n;
        v4u o; o.x = pk2(s[0 * 33], s[1 * 33]); o.y = pk2(s[2 * 33], s[3 * 33]); o.z = pk2(s[4 * 33], s[5 * 33]); o.w = pk2(s[6 * 33], s[7 * 33]);
        *(GAS v4u*)(WT + (size_t)dst_row(mode, n0 + n) * K + k0 + 8 * c) = o; }
    LDS_WAIT(); asm volatile("" ::: "memory");
}
__device__ __forceinline__ void rms_row_to_bf16(const float* xrow, const float* g, bf16* orow, int lane) {
    const GAS f32x4* xr = (const GAS f32x4*)xrow + lane; const GAS f32x4* gr = (const GAS f32x4*)g + lane;
    f32x4 v[4]; float s = 0.f;
#pragma unroll
    for (int j = 0; j < 4; ++j) { v[j] = xr[64 * j]; s += (v[j].x * v[j].x + v[j].y * v[j].y) + (v[j].z * v[j].z + v[j].w * v[j].w); }
    const float rstd = 1.f / sqrtf(wave_sum(s) * (1.f / DM) + 1e-6f);
    GAS unsigned long long* o8 = (GAS unsigned long long*)orow + lane;
#pragma unroll
    for (int j = 0; j < 4; ++j) { const f32x4 gg = gr[64 * j];
        o8[64 * j] = (unsigned long long)pk2(v[j].x * rstd * gg.x, v[j].y * rstd * gg.y) | ((unsigned long long)pk2(v[j].z * rstd * gg.z, v[j].w * rstd * gg.w) << 32); }
}
__device__ __forceinline__ int t5_bucket(int n) {
    if (n < 16) return n;
    int l = 16 + (int)(logf((float)n / 16.0f) / 2.0794415416798357f * 16.0f); return l < 31 ? l : 31;
}

typedef const __attribute__((address_space(4))) Args* KArgs;
__device__ __forceinline__ KArgs kargs_now() { KArgs p = (KArgs)__builtin_amdgcn_kernarg_segment_ptr(); asm volatile("" : "+s"(p)); return p; }
#define PTRS() KArgs A_ = kargs_now(); unsigned char* ws = A_->ws; (void)ws
#define SSQ_Q ((float*)(ws + WS_CTL))
#define SSQ_KV (SSQ_Q + MTOK)
#define SSQ2 (SSQ_Q + 2 * MTOK)
#define SSQ3 (SSQ_Q + 3 * MTOK)
#define P_BIAS2 ((float*)(ws + WS_BIAS))
#define P_W_IN_T ((bf16*)(ws + WS_WIN))
#define P_W_QB_T ((bf16*)(ws + WS_WQB))
#define P_W_KVB_T ((bf16*)(ws + WS_WKVB))
#define P_W_OUT_T ((bf16*)(ws + WS_WOUT))
#define P_W_UP_T ((bf16*)(ws + WS_WUP))
#define P_W_DOWN_T ((bf16*)(ws + WS_WDOWN))
#define P_CS ((float*)(ws + WS_CS))
#define P_H0 ((bf16*)(ws + WS_H0))
#define P_QA ((bf16*)(ws + WS_QA))
#define P_KA ((bf16*)(ws + WS_KA))
#define P_VA ((bf16*)(ws + WS_VA))
#define P_CQ ((bf16*)(ws + WS_CQ))
#define P_CKV ((bf16*)(ws + WS_CKV))
#define P_QB ((bf16*)(ws + WS_QB))
#define P_KB ((bf16*)(ws + WS_KB))
#define P_VB ((bf16*)(ws + WS_VB))
#define P_MIX ((bf16*)(ws + WS_MIX))
#define P_ACT ((bf16*)(ws + WS_ACT))
#define P_U ((bf16*)(ws + WS_U))

__global__ void __launch_bounds__(NWAVES * 64, 2) hymba_fwd(Args args) {
    extern __shared__ __attribute__((aligned(16))) unsigned char lds[];
    const int wave = __builtin_amdgcn_readfirstlane(threadIdx.x >> 6);
#define LANE_NOW(var) int var; asm volatile("v_mbcnt_lo_u32_b32 %0, -1, 0\n\tv_mbcnt_hi_u32_b32 %0, -1, %0" : "=v"(var))
    { LANE_NOW(l0_); if (wave == 0 && l0_ < 16) ((volatile LAS unsigned*)((LAS unsigned char*)lds + MISC_OFF))[l0_] = 0u; }
    __syncthreads();
#define GEO() int G = gridDim.x; asm volatile("" : "+s"(G)); int bx = blockIdx.x; asm volatile("" : "+s"(bx)); \
    const int vcu = (G % 8 == 0) ? (bx % 8) * (G / 8) + bx / 8 : bx, gw = vcu * NWAVES + wave, NGW = G * NWAVES, NGT = NGW * 64; (void)gw; (void)NGW; (void)NGT; (void)vcu
#define MK_XBAR(xb_) XcdBarrier xb_; { KArgs Ab_ = kargs_now(); xb_.bar = (unsigned*)(Ab_->ws + WS_BAR); xb_.x = xb_xcc_id(); xb_.st = (volatile LAS unsigned*)((LAS unsigned char*)lds + MISC_OFF); }
    { MK_XBAR(xb0_); LANE_NOW(l0_); if (wave == 0 && l0_ == 0) (void)xb_add(&xb0_.bar[XB_XCNT(xb0_.x)], 1u); }
#define GRID_BAR() do { MK_XBAR(xbb_); LANE_NOW(lb_); xcd_barrier(xbb_, wave == 0 && lb_ == 0); } while (0)

#ifndef NO_P0
    {   GEO();
    {
        PTRS(); const float* x = A_->in[0]; const float* rel_bias = A_->in[2]; const float* attn_g = A_->in[3]; const float* w_in = A_->in[4];
        const float* q_norm_g = A_->in[6]; const float* w_q_b = A_->in[7]; const float* kv_norm_g = A_->in[8]; const float* w_kv_b = A_->in[9]; const float* w_out = A_->in[12];
        const float* ffn_g = A_->in[13]; const float* w_up = A_->in[14]; const float* w_down = A_->in[17]; const int* pos = A_->pos;
        bf16* W_IN_T = P_W_IN_T; bf16* W_QB_T = P_W_QB_T; bf16* W_KVB_T = P_W_KVB_T; bf16* W_OUT_T = P_W_OUT_T; bf16* W_UP_T = P_W_UP_T; bf16* W_DOWN_T = P_W_DOWN_T; bf16* H0 = P_H0; float* CS = P_CS; float* bias2 = P_BIAS2;
        LANE_NOW(lane); const int gt = gw * 64 + lane;
        LAS float* scr = (LAS float*)((LAS unsigned char*)lds + wave * 16384);
        constexpr int I_IN = (DM / 64) * (IN_COLS / 32), I_QB = (QL / 64) * (QB_N / 32), I_KVB = (KVL / 64) * (KVB_N / 32), I_OUT = (DM / 64) * (DM / 32),
                      I_UP = (DM / 64) * (UP_N / 32), I_DOWN = (DFF / 64) * (DM / 32);
        constexpr int NITEMS = I_IN + I_QB + I_KVB + I_OUT + I_UP + I_DOWN;
        for (int it = gw; it < NITEMS; it += NGW) {
            int r = it;
            if (r < I_IN) { p0_transpose_item(w_in, DM, IN_COLS, nullptr, W_IN_T, 1, scr, r, lane); continue; } r -= I_IN;
            if (r < I_QB) { p0_transpose_item(w_q_b, QL, QB_N, q_norm_g, W_QB_T, 2, scr, r, lane); continue; } r -= I_QB;
            if (r < I_KVB) { p0_transpose_item(w_kv_b, KVL, KVB_N, kv_norm_g, W_KVB_T, 0, scr, r, lane); continue; } r -= I_KVB;
            if (r < I_OUT) { p0_transpose_item(w_out, DM, DM, nullptr, W_OUT_T, 0, scr, r, lane); continue; } r -= I_OUT;
            if (r < I_UP) { p0_transpose_item(w_up, DM, UP_N, ffn_g, W_UP_T, 3, scr, r, lane); continue; } r -= I_UP;
            p0_transpose_item(w_down, DFF, DM, nullptr, W_DOWN_T, 0, scr, r, lane);
        }
        for (int i = gt; i < (IN_N - IN_COLS) * DM / 8; i += NGT) ((GAS v4u*)(W_IN_T + (size_t)IN_COLS * DM))[i] = (v4u){0u, 0u, 0u, 0u};
        for (int m = gw; m < MTOK; m += NGW) rms_row_to_bf16(x + (size_t)m * DM, attn_g, H0 + (size_t)m * DM, lane);
        for (int i = gt; i < MTOK * 32; i += NGT) { const int t = i >> 5, d = i & 31;
            const float inv_freq = exp2f(-(float)d * (13.287712379549449f / 32.0f));
            const float ang = (float)pos[t] * inv_freq;
            double rev = (double)ang * 0.15915494309189535; rev -= rint(rev);
            const float fr = (float)rev;
            CS[(size_t)t * 64 + d] = __builtin_amdgcn_cosf(fr); CS[(size_t)t * 64 + 32 + d] = __builtin_amdgcn_sinf(fr); }
        for (int i = gt; i < 8 * 128; i += NGT) { const int h = i >> 7, dist = i & 127; bias2[i] = rel_bias[t5_bucket(dist) * 8 + h] * LOG2E_F; }
    }
    GRID_BAR();

    }
#endif
#ifndef NO_P1
    {   GEO();
    {
        PTRS();
        pg8::Gemm g{P_H0, P_W_IN_T, MTOK, IN_N, DM}; pg8::StaticOrder S; S.init(MTOK, IN_N, G, bx);
        pg8::EpiInProj E{P_QA, P_KA, P_VA, P_CQ, P_CKV, P_KB, SSQ_Q, SSQ_KV, P_CS};
        pg8::gemm_phase<pg8::EpiInProj, pg8::StaticOrder, true, true>((LAS unsigned char*)lds, g, S, E, wave);
    }
    GRID_BAR();

    }
#endif
#ifndef NO_P2
    {   GEO();
#ifndef NO_QB
    {
        PTRS();
        pg8::Gemm g{P_CQ, P_W_QB_T, MTOK, QB_N, QL}; pg8::StaticOrder S; S.init(MTOK, QB_N, G, bx);
        pg8::EpiQB E{P_QB, SSQ_Q, P_CS};
        pg8::gemm_phase<pg8::EpiQB, pg8::StaticOrder, true, true>((LAS unsigned char*)lds, g, S, E, wave);
    }
#endif
#ifndef NO_KVB
    {
        PTRS();
        pg8::Gemm g{P_CKV, P_W_KVB_T, MTOK, KVB_N, KVL}; pg8::StaticOrder S; S.init(MTOK, KVB_N, G, bx);
        pg8::EpiKVB E{P_KB, P_VB, SSQ_KV};
        pg8::gemm_phase<pg8::EpiKVB, pg8::StaticOrder, true, true>((LAS unsigned char*)lds, g, S, E, wave);
    }
#endif
    GRID_BAR();

    }
#endif
#ifndef NO_P3
    {   GEO();
#ifndef NO_MLA
    {
        PTRS(); bf16* QBb = P_QB; bf16* KBb = P_KB; bf16* VBb = P_VB; bf16* MIX = P_MIX;
        using BB = att::Body<192, 128, 768, 768, 512, 1024, false, MLA_NQR>;
        static_assert(BB::LDS_BYTES <= RING_BYTES, "attention LDS");
        constexpr int NQB = SEQ / 256, NIT = BATCH * 4 * (NQB / 2);
        for (int L = vcu; L < NIT; L += G)
            for (int pass = 0; pass < 2; ++pass) {
                const int bh = L / (NQB / 2), xq = L % (NQB / 2), b = bh >> 2, h = bh & 3, qb = pass ? NQB - 1 - xq : xq;
                BB::Ref r; const size_t row0 = (size_t)b * SEQ;
                r.Q = QBb + (row0 + (size_t)qb * 256) * 768 + 192 * h; r.K = KBb + row0 * 768 + 192 * h; r.V = VBb + row0 * 512 + 128 * h;
                r.O = MIX + (row0 + (size_t)qb * 256) * 1024 + 512 + 128 * h; r.P0 = qb * 256; r.bias = nullptr; r.sink = 0.f;
                BB::block(r, SEQ, SEQ, (char*)lds, wave);
            }
    }
#endif
#ifndef NO_SWA
    {
        PTRS(); bf16* QA = P_QA; bf16* KA = P_KA; bf16* VA = P_VA; bf16* MIX = P_MIX; const float* bias2 = P_BIAS2; const float* sinks = A_->in[5];
        using BA = att::Body<64, 64, 512, 128, 128, 1024, true, 4>;
        constexpr int NQB = SEQ / 256, NIT = BATCH * 8 * NQB;
        for (int L = vcu; L < NIT; L += G) {
            const int bh = L / NQB, qb = L % NQB, b = bh >> 3, h = bh & 7;
            BA::Ref r; const size_t row0 = (size_t)b * SEQ;
            r.Q = QA + (row0 + (size_t)qb * 256) * 512 + 64 * h; r.K = KA + row0 * 128 + 64 * (h >> 2); r.V = VA + row0 * 128 + 64 * (h >> 2);
            r.O = MIX + (row0 + (size_t)qb * 256) * 1024 + 64 * h; r.P0 = qb * 256; r.bias = bias2 + 128 * h; r.sink = sinks[h] * LOG2E_F;
            BA::block(r, SEQ, 128, (char*)lds, wave);
        }
    }
#endif
    GRID_BAR();

    }
#endif
#ifndef NO_P4
    {   GEO();
    { PTRS(); bf16* MIX = P_MIX; const float* a_out_g = A_->in[10]; const float* b_out_g = A_->in[11]; LANE_NOW(lane);
    for (int m = gw; m < MTOK; m += NGW) {
        GAS v4u* p = (GAS v4u*)(MIX + (size_t)m * 1024) + 2 * lane;
        const v4u a = p[0], b = p[1]; float f[16];
        const unsigned wv[8] = {a.x, a.y, a.z, a.w, b.x, b.y, b.z, b.w};
#pragma unroll
        for (int j = 0; j < 8; ++j) { f[2 * j] = __builtin_bit_cast(float, wv[j] << 16); f[2 * j + 1] = __builtin_bit_cast(float, wv[j] & 0xffff0000u); }
        float s = 0.f;
#pragma unroll
        for (int j = 0; j < 16; ++j) s += f[j] * f[j];
#pragma unroll
        for (int o = 1; o < 32; o <<= 1) s += __shfl_xor(s, o);
        const float rs = 1.f / sqrtf(s * (1.f / 512.f) + 1e-6f);
        const float* gp = (lane < 32 ? a_out_g : b_out_g) + 16 * (lane & 31);
        unsigned ow[8];
#pragma unroll
        for (int j = 0; j < 8; ++j) ow[j] = pk2(f[2 * j] * rs * gp[2 * j], f[2 * j + 1] * rs * gp[2 * j + 1]);
        p[0] = (v4u){ow[0], ow[1], ow[2], ow[3]}; p[1] = (v4u){ow[4], ow[5], ow[6], ow[7]};
    } }
    GRID_BAR();

    }
#endif
#ifndef NO_P5
    {   GEO();
    {
        PTRS();
        pg8::Gemm g{P_MIX, P_W_OUT_T, MTOK, DM, DM}; pg8::StaticOrder S; S.init(MTOK, DM, G, bx);
        pg8::EpiOut E{A_->in[0], A_->out, P_H0, SSQ2};
        pg8::gemm_phase<pg8::EpiOut, pg8::StaticOrder, true, true>((LAS unsigned char*)lds, g, S, E, wave);
    }
    GRID_BAR();

    }
#endif
#ifndef NO_P6
    {   GEO();
    { constexpr int b = 0;
        {
            PTRS();
            pg8::Gemm g{P_H0 + (size_t)b * SEQ * DM, P_W_UP_T, SEQ, UP_N, DM}; pg8::StaticOrder S; S.init(SEQ, UP_N, G, bx);
            pg8::EpiUp E{P_U, SSQ2 + (size_t)b * SEQ};
            pg8::gemm_phase<pg8::EpiUp, pg8::StaticOrder, true, true>((LAS unsigned char*)lds, g, S, E, wave);
        }
        GRID_BAR();
#ifndef NO_CONV
        {
            constexpr int NCG = DFF / 8, RCH = 64, NRC = SEQ / RCH;
            PTRS(); const bf16* U = P_U; bf16* ACT = P_ACT; const float* conv_w = A_->in[15]; const float* conv_b = A_->in[16];
            LANE_NOW(lane); const int gt = gw * 64 + lane;
            for (int task = gt; task < NCG * NRC; task += NGT) {
                const int cgi = task % NCG, rc = task / NCG, j0 = cgi * 8, t0 = rc * RCH;
                const int ug = 256 * (j0 >> 7) + (j0 & 127);
                float wg[3][8], wv[3][8], bg[8], bv[8];
                { const GAS f32x4* cwp = (const GAS f32x4*)conv_w + (j0 >> 2); const GAS f32x4* cbp = (const GAS f32x4*)conv_b + (j0 >> 2);
#pragma unroll
                for (int k = 0; k < 3; ++k) { const f32x4 a0 = cwp[k * (UP_N / 4)], a1 = cwp[k * (UP_N / 4) + 1], c0 = cwp[k * (UP_N / 4) + DFF / 4], c1 = cwp[k * (UP_N / 4) + DFF / 4 + 1];
#pragma unroll
                    for (int e = 0; e < 4; ++e) { wg[k][e] = a0[e]; wg[k][4 + e] = a1[e]; wv[k][e] = c0[e]; wv[k][4 + e] = c1[e]; } }
                const f32x4 a0 = cbp[0], a1 = cbp[1], c0 = cbp[DFF / 4], c1 = cbp[DFF / 4 + 1];
#pragma unroll
                for (int e = 0; e < 4; ++e) { bg[e] = a0[e]; bg[4 + e] = a1[e]; bv[e] = c0[e]; bv[4 + e] = c1[e]; } }
                float g2[8], g1[8], v2[8], v1[8];
#pragma unroll
                for (int e = 0; e < 8; ++e) { g2[e] = 0.f; g1[e] = 0.f; v2[e] = 0.f; v1[e] = 0.f; }
                if (t0 > 0) {
                    const v4u a2 = *(const GAS v4u*)(U + (size_t)(t0 - 2) * UP_N + ug), a1 = *(const GAS v4u*)(U + (size_t)(t0 - 1) * UP_N + ug);
                    const v4u c2 = *(const GAS v4u*)(U + (size_t)(t0 - 2) * UP_N + ug + 128), c1 = *(const GAS v4u*)(U + (size_t)(t0 - 1) * UP_N + ug + 128);
                    const unsigned A2[4] = {a2.x, a2.y, a2.z, a2.w}, A1[4] = {a1.x, a1.y, a1.z, a1.w}, C2[4] = {c2.x, c2.y, c2.z, c2.w}, C1[4] = {c1.x, c1.y, c1.z, c1.w};
#pragma unroll
                    for (int e = 0; e < 4; ++e) { g2[2 * e] = __builtin_bit_cast(float, A2[e] << 16); g2[2 * e + 1] = __builtin_bit_cast(float, A2[e] & 0xffff0000u);
                        g1[2 * e] = __builtin_bit_cast(float, A1[e] << 16); g1[2 * e + 1] = __builtin_bit_cast(float, A1[e] & 0xffff0000u);
                        v2[2 * e] = __builtin_bit_cast(float, C2[e] << 16); v2[2 * e + 1] = __builtin_bit_cast(float, C2[e] & 0xffff0000u);
                        v1[2 * e] = __builtin_bit_cast(float, C1[e] << 16); v1[2 * e + 1] = __builtin_bit_cast(float, C1[e] & 0xffff0000u); }
                }
                for (int t = t0; t < t0 + RCH; ++t) {
                    const v4u a0 = *(const GAS v4u*)(U + (size_t)t * UP_N + ug), c0 = *(const GAS v4u*)(U + (size_t)t * UP_N + ug + 128);
                    const unsigned A0[4] = {a0.x, a0.y, a0.z, a0.w}, C0[4] = {c0.x, c0.y, c0.z, c0.w};
                    float g0[8], v0[8], r[8];
#pragma unroll
                    for (int e = 0; e < 4; ++e) { g0[2 * e] = __builtin_bit_cast(float, A0[e] << 16); g0[2 * e + 1] = __builtin_bit_cast(float, A0[e] & 0xffff0000u);
                        v0[2 * e] = __builtin_bit_cast(float, C0[e] << 16); v0[2 * e + 1] = __builtin_bit_cast(float, C0[e] & 0xffff0000u); }
#pragma unroll
                    for (int e = 0; e < 8; ++e) {
                        const float gg = wg[0][e] * g2[e] + wg[1][e] * g1[e] + wg[2][e] * g0[e] + bg[e];
                        const float vv = wv[0][e] * v2[e] + wv[1][e] * v1[e] + wv[2][e] * v0[e] + bv[e];
                        r[e] = gg * __builtin_amdgcn_rcpf(1.f + __builtin_amdgcn_exp2f(-gg * LOG2E_F)) * vv;
                        g2[e] = g1[e]; g1[e] = g0[e]; v2[e] = v1[e]; v1[e] = v0[e];
                    }
                    *(GAS v4u*)(ACT + ((size_t)b * SEQ + t) * DFF + j0) = (v4u){pk2(r[0], r[1]), pk2(r[2], r[3]), pk2(r[4], r[5]), pk2(r[6], r[7])};
                }
            }
        }
#endif
        GRID_BAR();
    }
    { constexpr int b = 1;
        {
            PTRS();
            pg8::Gemm g{P_H0 + (size_t)b * SEQ * DM, P_W_UP_T, SEQ, UP_N, DM}; pg8::StaticOrder S; S.init(SEQ, UP_N, G, bx);
            pg8::EpiUp E{P_U, SSQ2 + (size_t)b * SEQ};
            pg8::gemm_phase<pg8::EpiUp, pg8::StaticOrder, true, true>((LAS unsigned char*)lds, g, S, E, wave);
        }
        GRID_BAR();
#ifndef NO_CONV
        {
            constexpr int NCG = DFF / 8, RCH = 64, NRC = SEQ / RCH;
            PTRS(); const bf16* U = P_U; bf16* ACT = P_ACT; const float* conv_w = A_->in[15]; const float* conv_b = A_->in[16];
            LANE_NOW(lane); const int gt = gw * 64 + lane;
            for (int task = gt; task < NCG * NRC; task += NGT) {
                const int cgi = task % NCG, rc = task / NCG, j0 = cgi * 8, t0 = rc * RCH;
                const int ug = 256 * (j0 >> 7) + (j0 & 127);
                float wg[3][8], wv[3][8], bg[8], bv[8];
                { const GAS f32x4* cwp = (const GAS f32x4*)conv_w + (j0 >> 2); const GAS f32x4* cbp = (const GAS f32x4*)conv_b + (j0 >> 2);
#pragma unroll
                for (int k = 0; k < 3; ++k) { const f32x4 a0 = cwp[k * (UP_N / 4)], a1 = cwp[k * (UP_N / 4) + 1], c0 = cwp[k * (UP_N / 4) + DFF / 4], c1 = cwp[k * (UP_N / 4) + DFF / 4 + 1];
#pragma unroll
                    for (int e = 0; e < 4; ++e) { wg[k][e] = a0[e]; wg[k][4 + e] = a1[e]; wv[k][e] = c0[e]; wv[k][4 + e] = c1[e]; } }
                const f32x4 a0 = cbp[0], a1 = cbp[1], c0 = cbp[DFF / 4], c1 = cbp[DFF / 4 + 1];
#pragma unroll
                for (int e = 0; e < 4; ++e) { bg[e] = a0[e]; bg[4 + e] = a1[e]; bv[e] = c0[e]; bv[4 + e] = c1[e]; } }
                float g2[8], g1[8], v2[8], v1[8];
#pragma unroll
                for (int e = 0; e < 8; ++e) { g2[e] = 0.f; g1[e] = 0.f; v2[e] = 0.f; v1[e] = 0.f; }
                if (t0 > 0) {
                    const v4u a2 = *(const GAS v4u*)(U + (size_t)(t0 - 2) * UP_N + ug), a1 = *(const GAS v4u*)(U + (size_t)(t0 - 1) * UP_N + ug);
                    const v4u c2 = *(const GAS v4u*)(U + (size_t)(t0 - 2) * UP_N + ug + 128), c1 = *(const GAS v4u*)(U + (size_t)(t0 - 1) * UP_N + ug + 128);
                    const unsigned A2[4] = {a2.x, a2.y, a2.z, a2.w}, A1[4] = {a1.x, a1.y, a1.z, a1.w}, C2[4] = {c2.x, c2.y, c2.z, c2.w}, C1[4] = {c1.x, c1.y, c1.z, c1.w};
#pragma unroll
                    for (int e = 0; e < 4; ++e) { g2[2 * e] = __builtin_bit_cast(float, A2[e] << 16); g2[2 * e + 1] = __builtin_bit_cast(float, A2[e] & 0xffff0000u);
                        g1[2 * e] = __builtin_bit_cast(float, A1[e] << 16); g1[2 * e + 1] = __builtin_bit_cast(float, A1[e] & 0xffff0000u);
                        v2[2 * e] = __builtin_bit_cast(float, C2[e] << 16); v2[2 * e + 1] = __builtin_bit_cast(float, C2[e] & 0xffff0000u);
                        v1[2 * e] = __builtin_bit_cast(float, C1[e] << 16); v1[2 * e + 1] = __builtin_bit_cast(float, C1[e] & 0xffff0000u); }
                }
                for (int t = t0; t < t0 + RCH; ++t) {
                    const v4u a0 = *(const GAS v4u*)(U + (size_t)t * UP_N + ug), c0 = *(const GAS v4u*)(U + (size_t)t * UP_N + ug + 128);
                    const unsigned A0[4] = {a0.x, a0.y, a0.z, a0.w}, C0[4] = {c0.x, c0.y, c0.z, c0.w};
                    float g0[8], v0[8], r[8];
#pragma unroll
                    for (int e = 0; e < 4; ++e) { g0[2 * e] = __builtin_bit_cast(float, A0[e] << 16); g0[2 * e + 1] = __builtin_bit_cast(float, A0[e] & 0xffff0000u);
                        v0[2 * e] = __builtin_bit_cast(float, C0[e] << 16); v0[2 * e + 1] = __builtin_bit_cast(float, C0[e] & 0xffff0000u); }
#pragma unroll
                    for (int e = 0; e < 8; ++e) {
                        const float gg = wg[0][e] * g2[e] + wg[1][e] * g1[e] + wg[2][e] * g0[e] + bg[e];
                        const float vv = wv[0][e] * v2[e] + wv[1][e] * v1[e] + wv[2][e] * v0[e] + bv[e];
                        r[e] = gg * __builtin_amdgcn_rcpf(1.f + __builtin_amdgcn_exp2f(-gg * LOG2E_F)) * vv;
                        g2[e] = g1[e]; g1[e] = g0[e]; v2[e] = v1[e]; v1[e] = v0[e];
                    }
                    *(GAS v4u*)(ACT + ((size_t)b * SEQ + t) * DFF + j0) = (v4u){pk2(r[0], r[1]), pk2(r[2], r[3]), pk2(r[4], r[5]), pk2(r[6], r[7])};
                }
            }
        }
#endif
        GRID_BAR();
    }

    }
#endif
#ifndef NO_P7
    {   GEO();
    {
        PTRS();
        pg8::Gemm g{P_ACT, P_W_DOWN_T, MTOK, DM, DFF}; pg8::StaticOrder S; S.init(MTOK, DM, G, bx);
        pg8::EpiDown E{A_->out, SSQ3};
        pg8::gemm_phase<pg8::EpiDown, pg8::StaticOrder, true, true>((LAS unsigned char*)lds, g, S, E, wave);
    }
    GRID_BAR();

    }
#endif
#ifndef NO_P8
    {   GEO();
    { PTRS(); float* out = A_->out; const float* final_g = A_->in[18]; const float* ssq3 = SSQ3; LANE_NOW(lane);
    for (int m = gw; m < MTOK; m += NGW) {
        GAS f32x4* xr = (GAS f32x4*)(out + (size_t)m * DM) + lane; const GAS f32x4* gr = (const GAS f32x4*)final_g + lane;
        const float rs = 1.f / sqrtf(ssq3[m] * (1.f / DM) + 1e-6f);
#pragma unroll
        for (int j = 0; j < 4; ++j) { const f32x4 v = xr[64 * j], gg = gr[64 * j]; xr[64 * j] = v * rs * gg; }
    } }
    }
#endif
}

extern "C" void kernel_launch(void* const* d_in, const int* in_sizes, int n_in, void* d_out, int out_size, void* d_ws, size_t ws_size, hipStream_t stream) {
    static int grid = 0;
    if (grid == 0) {
        if (n_in != 19 || in_sizes[0] != MTOK * DM || out_size != MTOK * DM || ws_size < WS_END) {
            fprintf(stderr, "kernel_launch: unexpected shapes (n_in %d, in0 %d, out %d, ws %zu)\n", n_in, n_in > 0 ? in_sizes[0] : -1, out_size, ws_size); grid = -1; return; }
        int dev = 0, cus = 0, per_cu = 0;
        (void)hipGetDevice(&dev); (void)hipDeviceGetAttribute(&cus, hipDeviceAttributeMultiprocessorCount, dev);
        if (hipFuncSetAttribute((const void*)hymba_fwd, hipFuncAttributeMaxDynamicSharedMemorySize, LDS_BYTES) != hipSuccess) { fprintf(stderr, "kernel_launch: hipFuncSetAttribute failed\n"); grid = -1; return; }
        if (hipOccupancyMaxActiveBlocksPerMultiprocessor(&per_cu, (const void*)hymba_fwd, NWAVES * 64, LDS_BYTES) != hipSuccess || per_cu < 1) { fprintf(stderr, "kernel_launch: occupancy query says %d\n", per_cu); per_cu = 1; }
        (void)hipGetLastError();
        grid = cus * 1;
        if (grid <= 0) grid = 256;
    }
    if (grid < 0) return;
    (void)hipMemsetAsync((char*)d_ws + WS_CTL, 0, CTL_ZERO_BYTES, stream);
    Args a{};
    for (int i = 0; i < 19; ++i) a.in[i] = (const float*)d_in[i];
    a.pos = (const int*)d_in[1]; a.out = (float*)d_out; a.ws = (unsigned char*)d_ws;
    void* kargs[] = {&a};
    hipError_t e = hipLaunchCooperativeKernel((const void*)hymba_fwd, dim3(grid), dim3(NWAVES * 64), kargs, LDS_BYTES, stream);
    if (e != hipSuccess) fprintf(stderr, "kernel_launch: cooperative launch failed: %s (grid %d)\n", hipGetErrorString(e), grid);
}
```

```cpp
#include <hip/hip_runtime.h>
#include <hip/hip_cooperative_groups.h>
#include <cstdio>
#include <cstdint>
namespace cg = cooperative_groups;

namespace pg8 {
#define PG8_LAS __attribute__((address_space(3)))
typedef unsigned short bf16_t;
typedef short bf16x8 __attribute__((ext_vector_type(8)));
typedef float f32x4 __attribute__((ext_vector_type(4)));
typedef unsigned u32x4 __attribute__((ext_vector_type(4)));
constexpr int BM = 256, BK = 64, HALF = 128, HTB = HALF * BK * 2  , STAGE_BYTES = 8 * HTB, NXCD = 8, WGM = 8;

__host__ __device__ __forceinline__ int lds_byte(int r, int c) { const int st = (r >> 4) * 2 + (c >> 5), rr = r & 15, cc = c & 31, ob = rr * 64 + cc * 2; return st * 1024 + (ob ^ (((ob >> 9) & 1) << 5)); }
__host__ __device__ __forceinline__ void stage_rc(int b, int& R, int& C) { const int st = b / 1024, sb = b % 1024, swz = sb ^ (((sb >> 9) & 1) << 5); R = (st >> 1) * 16 + swz / 64; C = (st & 1) * 32 + (swz % 64) / 2; }
__host__ __device__ __forceinline__ int perm32(int rho) { const int n = rho >> 4, i = rho & 15; return 8 * (i >> 2) + 4 * n + (i & 3); }

struct Unit { int pm, pn; };
struct Gemm { const bf16_t* A; const bf16_t* Bt; int M, N, K; };

struct StaticOrder {
    int nM, nN, nwg, G, c;
    __host__ __device__ void init(int M, int N, int G_, int c_) { nM = M / BM; nN = N / BM; nwg = nM * nN; G = G_; c = c_; }
    __host__ __device__ bool next(int i, Unit& u) const {
        const long L = (long)i * G + c; if (L >= nwg) return false;
        int wgid = (int)L; { const int q = nwg / NXCD, r = nwg % NXCD, xcd = wgid % NXCD, off = wgid / NXCD; wgid = (xcd < r ? xcd * (q + 1) : r * (q + 1) + (xcd - r) * q) + off; }
        const int nig = WGM * nN, gid = wgid / nig, fm = gid * WGM, gsz = (nM - fm) < WGM ? (nM - fm) : WGM;
        u.pm = fm + ((wgid % nig) % gsz); u.pn = (wgid % nig) / gsz; return true;
    }
    __device__ __forceinline__ void a_ready(const Unit&) const {}
    __device__ __forceinline__ void done(const Unit&) const {}
};


typedef unsigned u32x2 __attribute__((ext_vector_type(2)));
__device__ __forceinline__ unsigned cvt_pk_bf16(float lo, float hi) { unsigned r; asm volatile("v_cvt_pk_bf16_f32 %0, %1, %2" : "=v"(r) : "v"(lo), "v"(hi)); return r; }
__device__ __forceinline__ u32x4 pack8(f32x4 a, f32x4 b) { u32x4 w; w.x = cvt_pk_bf16(a[0], a[1]); w.y = cvt_pk_bf16(a[2], a[3]); w.z = cvt_pk_bf16(b[0], b[1]); w.w = cvt_pk_bf16(b[2], b[3]); return w; }
__device__ __forceinline__ u32x2 pack4(f32x4 a) { u32x2 w; w.x = cvt_pk_bf16(a[0], a[1]); w.y = cvt_pk_bf16(a[2], a[3]); return w; }
__device__ __forceinline__ float dot4(f32x4 a) { return (a[0] * a[0] + a[1] * a[1]) + (a[2] * a[2] + a[3] * a[3]); }
__device__ __forceinline__ float red_fq(float s) { s += __shfl_xor(s, 16); s += __shfl_xor(s, 32); return s; }

constexpr float RMS_EPS = 1e-6f;
constexpr float LOG2E = 1.4426950408889634f;
constexpr float C_A = 0.125f * LOG2E;
constexpr float C_B = 0.07216878364870322f * LOG2E;

struct EpiInProj {
    static constexpr bool PERM = true, AFTER_DRAIN = false;
    bf16_t *QA, *KA, *VA, *CQ, *CKV, *KB; float *ssq_q, *ssq_kv; const float* cs;
    __device__ __forceinline__ void operator()(const f32x4 (&acc)[2][2][4][2], const Unit& u, int wr, int wc, int fr, int fq) const {
        const int row0 = u.pm * BM + wr * 64 + fr, cw = wc * 32 + 8 * fq, pn = u.pn;
#pragma unroll
        for (int ai = 0; ai < 2; ++ai)
#pragma unroll
            for (int m = 0; m < 4; ++m) {
                const unsigned row = (unsigned)(row0 + ai * HALF + m * 16);
                if (pn < 2) {
#pragma unroll
                    for (int bj = 0; bj < 2; ++bj) *(u32x4*)(QA + row * 512 + pn * 256 + bj * HALF + cw) = pack8(acc[ai][bj][m][0] * C_A, acc[ai][bj][m][1] * C_A);
                } else if (pn == 2) {
                    *(u32x4*)(KA + row * 128 + cw) = pack8(acc[ai][0][m][0], acc[ai][0][m][1]);
                    *(u32x4*)(VA + row * 128 + cw) = pack8(acc[ai][1][m][0], acc[ai][1][m][1]);
                } else if (pn == 3) {
                    float s = 0.f;
#pragma unroll
                    for (int bj = 0; bj < 2; ++bj) { const f32x4 v0 = acc[ai][bj][m][0], v1 = acc[ai][bj][m][1]; s += dot4(v0) + dot4(v1);
                        *(u32x4*)(CQ + row * 256 + bj * HALF + cw) = pack8(v0, v1); }
                    s = red_fq(s); if (fq == 0) atomicAdd(ssq_q + row, s);
                } else {
                    { const f32x4 v0 = acc[ai][0][m][0], v1 = acc[ai][0][m][1]; float s = dot4(v0) + dot4(v1);
                      *(u32x4*)(CKV + row * 128 + cw) = pack8(v0, v1); s = red_fq(s); if (fq == 0) atomicAdd(ssq_kv + row, s); }
                    if (wc < 2) {
                        const int d = 4 * (4 * wc + fq); const f32x4 x1 = acc[ai][1][m][0], x2 = acc[ai][1][m][1];
                        const f32x4 c = *(const f32x4*)(cs + row * 64 + d), sn = *(const f32x4*)(cs + row * 64 + 32 + d);
                        const u32x2 y1 = pack4(x1 * c - x2 * sn), y2 = pack4(x1 * sn + x2 * c);
#pragma unroll
                        for (int h = 0; h < 4; ++h) { *(u32x2*)(KB + row * 768 + 192 * h + 128 + d) = y1; *(u32x2*)(KB + row * 768 + 192 * h + 160 + d) = y2; }
                    }
                }
                asm volatile("" ::: "memory");
            }
    }
};
struct EpiQB {
    static constexpr bool PERM = true, AFTER_DRAIN = false;
    bf16_t* QB; const float* ssq_q; const float* cs;
    __device__ __forceinline__ void operator()(const f32x4 (&acc)[2][2][4][2], const Unit& u, int wr, int wc, int fr, int fq) const {
        const int row0 = u.pm * BM + wr * 64 + fr, cw = wc * 32 + 8 * fq, pn = u.pn;
#pragma unroll
        for (int ai = 0; ai < 2; ++ai)
#pragma unroll
            for (int m = 0; m < 4; ++m) {
                const unsigned row = (unsigned)(row0 + ai * HALF + m * 16);
                const float rs = __builtin_amdgcn_rsqf(ssq_q[row] * (1.0f / 256.0f) + RMS_EPS) * C_B;
                if (pn < 2) {
#pragma unroll
                    for (int bj = 0; bj < 2; ++bj) *(u32x4*)(QB + row * 768 + 192 * (2 * pn + bj) + cw) = pack8(acc[ai][bj][m][0] * rs, acc[ai][bj][m][1] * rs);
                } else {
                    const int d = 4 * (4 * (wc & 1) + fq);
                    const f32x4 c = *(const f32x4*)(cs + row * 64 + d), sn = *(const f32x4*)(cs + row * 64 + 32 + d);
#pragma unroll
                    for (int bj = 0; bj < 2; ++bj) { const int h = 2 * bj + (wc >> 1); const f32x4 x1 = acc[ai][bj][m][0] * rs, x2 = acc[ai][bj][m][1] * rs;
                        *(u32x2*)(QB + row * 768 + 192 * h + 128 + d) = pack4(x1 * c - x2 * sn); *(u32x2*)(QB + row * 768 + 192 * h + 160 + d) = pack4(x1 * sn + x2 * c); }
                }
                asm volatile("" ::: "memory");
            }
    }
};
struct EpiKVB {
    static constexpr bool PERM = true, AFTER_DRAIN = false;
    bf16_t *KB, *VB; const float* ssq_kv;
    __device__ __forceinline__ void operator()(const f32x4 (&acc)[2][2][4][2], const Unit& u, int wr, int wc, int fr, int fq) const {
        const int row0 = u.pm * BM + wr * 64 + fr, cw = wc * 32 + 8 * fq, h = u.pn;
#pragma unroll
        for (int ai = 0; ai < 2; ++ai)
#pragma unroll
            for (int m = 0; m < 4; ++m) {
                const unsigned row = (unsigned)(row0 + ai * HALF + m * 16);
                const float rs = __builtin_amdgcn_rsqf(ssq_kv[row] * (1.0f / 128.0f) + RMS_EPS);
                *(u32x4*)(KB + row * 768 + 192 * h + cw) = pack8(acc[ai][0][m][0] * rs, acc[ai][0][m][1] * rs);
                *(u32x4*)(VB + row * 512 + 128 * h + cw) = pack8(acc[ai][1][m][0] * rs, acc[ai][1][m][1] * rs);
                asm volatile("" ::: "memory");
            }
    }
};
struct EpiOut {
    static constexpr bool PERM = false, AFTER_DRAIN = false;
    const float* x; float* X1; bf16_t* HB; float* ssq;
    __device__ __forceinline__ void operator()(const f32x4 (&acc)[2][2][4][2], const Unit& u, int wr, int wc, int fr, int fq) const {
        const int row0 = u.pm * BM + wr * 64 + fr, col0 = u.pn * BM + wc * 32 + 4 * fq;
#pragma unroll
        for (int ai = 0; ai < 2; ++ai)
#pragma unroll
            for (int m = 0; m < 4; ++m) {
                const unsigned row = (unsigned)(row0 + ai * HALF + m * 16); const unsigned off = row * 1024u + (unsigned)col0; float s = 0.f;
#pragma unroll
                for (int bj = 0; bj < 2; ++bj)
#pragma unroll
                    for (int n = 0; n < 2; ++n) { const unsigned o = off + (unsigned)(bj * HALF + n * 16); const f32x4 v = *(const f32x4*)(x + o) + acc[ai][bj][m][n];
                        *(f32x4*)(X1 + o) = v; *(u32x2*)(HB + o) = pack4(v); s += dot4(v); }
                s = red_fq(s); if (fq == 0) atomicAdd(ssq + row, s);
                asm volatile("" ::: "memory");
            }
    }
};
struct EpiUp {
    static constexpr bool PERM = true, AFTER_DRAIN = false;
    bf16_t* U; const float* ssq;
    __device__ __forceinline__ void operator()(const f32x4 (&acc)[2][2][4][2], const Unit& u, int wr, int wc, int fr, int fq) const {
        const int row0 = u.pm * BM + wr * 64 + fr, cw = u.pn * BM + wc * 32 + 8 * fq;
#pragma unroll
        for (int ai = 0; ai < 2; ++ai)
#pragma unroll
            for (int m = 0; m < 4; ++m) {
                const unsigned row = (unsigned)(row0 + ai * HALF + m * 16);
                const float rs = __builtin_amdgcn_rsqf(ssq[row] * (1.0f / 1024.0f) + RMS_EPS);
#pragma unroll
                for (int bj = 0; bj < 2; ++bj) *(u32x4*)(U + row * 5632 + bj * HALF + cw) = pack8(acc[ai][bj][m][0] * rs, acc[ai][bj][m][1] * rs);
                asm volatile("" ::: "memory");
            }
    }
};
template <int CTRL> __device__ __forceinline__ float dppmov(float old, float src) {
    return __builtin_bit_cast(float, __builtin_amdgcn_update_dpp(__builtin_bit_cast(int, old), __builtin_bit_cast(int, src), CTRL, 0xf, 0xf, false)); }
template <int CTRL> __device__ __forceinline__ f32x4 dppmov4(f32x4 old, f32x4 src) { f32x4 r; r[0] = dppmov<CTRL>(old[0], src[0]); r[1] = dppmov<CTRL>(old[1], src[1]); r[2] = dppmov<CTRL>(old[2], src[2]); r[3] = dppmov<CTRL>(old[3], src[3]); return r; }
struct EpiUpConv {
    static constexpr bool PERM = true, AFTER_DRAIN = false;
    bf16_t* ACT; float* EDGE; const float* ssq; const float* conv_w; const float* conv_b;
    __device__ __forceinline__ void operator()(const f32x4 (&acc)[2][2][4][2], const Unit& u, int wr, int wc, int fr, int fq) const {
        const int row0 = u.pm * BM + wr * 64 + fr, pn = u.pn;
        float rs[2][4];
#pragma unroll
        for (int ai = 0; ai < 2; ++ai)
#pragma unroll
            for (int m = 0; m < 4; ++m) rs[ai][m] = __builtin_amdgcn_rsqf(ssq[(unsigned)(row0 + ai * HALF + m * 16)] * (1.0f / 1024.0f) + RMS_EPS);
#pragma unroll
        for (int n = 0; n < 2; ++n) {
            const int ct = wc * 32 + 8 * fq + 4 * n;
            const unsigned ch = (unsigned)(pn * 128 + ct);
            const f32x4 wg0 = *(const f32x4*)(conv_w + ch), wg1 = *(const f32x4*)(conv_w + 5632u + ch), wg2 = *(const f32x4*)(conv_w + 11264u + ch), bg = *(const f32x4*)(conv_b + ch);
            const f32x4 wv0 = *(const f32x4*)(conv_w + 2816u + ch), wv1 = *(const f32x4*)(conv_w + 5632u + 2816u + ch), wv2 = *(const f32x4*)(conv_w + 11264u + 2816u + ch), bv = *(const f32x4*)(conv_b + 2816u + ch);
#pragma unroll
            for (int ai = 0; ai < 2; ++ai) {
                f32x4 pg = {0.f, 0.f, 0.f, 0.f}, pv = {0.f, 0.f, 0.f, 0.f};
                const unsigned chunk = (unsigned)(u.pm * 4 + ai * 2 + wr);
                float* eb = EDGE + ((size_t)(chunk * 22u + (unsigned)pn) * 4u) * 256u + ct;
#pragma unroll
                for (int m = 0; m < 4; ++m) {
                    const f32x4 cg = acc[ai][0][m][n] * rs[ai][m], cv = acc[ai][1][m][n] * rs[ai][m];
                    const f32x4 bg1 = dppmov4<0x121>(cg, pg), bg2 = dppmov4<0x122>(cg, pg), bv1 = dppmov4<0x121>(cv, pv), bv2 = dppmov4<0x122>(cv, pv);
                    const f32x4 g1 = dppmov4<0x111>(bg1, cg), g2 = dppmov4<0x112>(bg2, cg), v1 = dppmov4<0x111>(bv1, cv), v2 = dppmov4<0x112>(bv2, cv);
                    const f32x4 gs = wg0 * g2 + wg1 * g1 + wg2 * cg + bg, vs = wv0 * v2 + wv1 * v1 + wv2 * cv + bv;
                    f32x4 r;
#pragma unroll
                    for (int i = 0; i < 4; ++i) r[i] = gs[i] * __builtin_amdgcn_rcpf(1.f + __builtin_amdgcn_exp2f(-gs[i] * LOG2E)) * vs[i];
                    const unsigned row = (unsigned)(row0 + ai * HALF + m * 16);
                    if (m == 0) { if (fr >= 2) *(u32x2*)(ACT + row * 2816u + ch) = pack4(r);
                                  else { *(f32x4*)(eb + fr * 256) = cg; *(f32x4*)(eb + fr * 256 + 128) = cv; } }
                    else *(u32x2*)(ACT + row * 2816u + ch) = pack4(r);
                    if (m == 3) { if (fr >= 14) { *(f32x4*)(eb + (fr - 12) * 256) = cg; *(f32x4*)(eb + (fr - 12) * 256 + 128) = cv; } }
                    pg = cg; pv = cv;
                }
                asm volatile("" ::: "memory");
            }
        }
    }
};
struct EpiDown {
    static constexpr bool PERM = false, AFTER_DRAIN = false;
    float* X; float* ssq;
    __device__ __forceinline__ void operator()(const f32x4 (&acc)[2][2][4][2], const Unit& u, int wr, int wc, int fr, int fq) const {
        const int row0 = u.pm * BM + wr * 64 + fr, col0 = u.pn * BM + wc * 32 + 4 * fq;
#pragma unroll
        for (int ai = 0; ai < 2; ++ai)
#pragma unroll
            for (int m = 0; m < 4; ++m) {
                const unsigned row = (unsigned)(row0 + ai * HALF + m * 16); const unsigned off = row * 1024u + (unsigned)col0; float s = 0.f;
#pragma unroll
                for (int bj = 0; bj < 2; ++bj)
#pragma unroll
                    for (int n = 0; n < 2; ++n) { const unsigned o = off + (unsigned)(bj * HALF + n * 16); const f32x4 v = *(const f32x4*)(X + o) + acc[ai][bj][m][n];
                        *(f32x4*)(X + o) = v; s += dot4(v); }
                s = red_fq(s); if (fq == 0) atomicAdd(ssq + row, s);
                asm volatile("" ::: "memory");
            }
    }
};

template <class Epi, class Sched, bool ALIGN_EPI = false, bool SP2 = false>
__device__ __forceinline__ void gemm_phase(PG8_LAS unsigned char* lds, const Gemm g, const Sched& S, const Epi& E, const int wid) {
    int lane_v; asm volatile("v_mbcnt_lo_u32_b32 %0, -1, 0\n\tv_mbcnt_hi_u32_b32 %0, -1, %0" : "=v"(lane_v));
    const int lane = lane_v, tid = wid * 64 + lane, wr = wid >> 2, wc = wid & 3, fr = lane & 15, fq = lane >> 4;
    int K_o = g.K; asm volatile("" : "+s"(K_o));
    const int K = K_o, nt = K / BK;
    unsigned voffA[2], voffB[2];
#pragma unroll
    for (int i = 0; i < 2; ++i) { int R, C; stage_rc(tid * 16 + i * 8192, R, C); const int Rb = Epi::PERM ? ((R & ~31) + perm32(R & 31)) : R;
        voffA[i] = (unsigned)(R * K + C) * 2u; voffB[i] = (unsigned)(Rb * K + C) * 2u; }
    const size_t kstep = (size_t)(BK * 2);
    const size_t hstep = (size_t)HALF * K * 2;
    const size_t tstep = 2 * hstep;
    const unsigned ldsw = (unsigned)wid * 1024u;
    const int aoff = lds_byte(wr * 64 + fr, fq * 8), boff = lds_byte(wc * 32 + fr, fq * 8);
#define PG8_SA(b, h) (((b) * 2 + (h)) * HTB)
#define PG8_SB(b, h) ((4 + (b) * 2 + (h)) * HTB)
#define PG8_STAGE(bufoff, gbase, voff) do { _Pragma("unroll") for (int _i = 0; _i < 2; ++_i) \
        __builtin_amdgcn_global_load_lds((const unsigned*)((const char*)(gbase) + (voff)[_i]), (PG8_LAS unsigned*)(lds + (bufoff) + ldsw + _i * 8192), 16, 0, 0); } while (0)
#define PG8_LDA(dst, b, h) do { _Pragma("unroll") for (int m = 0; m < 4; ++m) _Pragma("unroll") for (int k = 0; k < 2; ++k) dst[m][k] = *(const PG8_LAS bf16x8*)(lds + PG8_SA(b, h) + aoff + m * 2048 + k * 1024); } while (0)
#define PG8_LDB(dst, b, h) do { _Pragma("unroll") for (int n = 0; n < 2; ++n) _Pragma("unroll") for (int k = 0; k < 2; ++k) dst[n][k] = *(const PG8_LAS bf16x8*)(lds + PG8_SB(b, h) + boff + n * 2048 + k * 1024); } while (0)
#define PG8_MMA(ai, bj, At, Bt) do { __builtin_amdgcn_s_setprio(1); _Pragma("unroll") for (int m = 0; m < 4; ++m) _Pragma("unroll") for (int n = 0; n < 2; ++n) _Pragma("unroll") for (int k = 0; k < 2; ++k) \
        acc[ai][bj][m][n] = __builtin_amdgcn_mfma_f32_16x16x32_bf16(Bt[n][k], At[m][k], acc[ai][bj][m][n], 0, 0, 0); __builtin_amdgcn_s_setprio(0); } while (0)
#define PG8_WAIT_V(n) asm volatile("s_waitcnt vmcnt(" #n ")" ::: "memory")
#define PG8_WAIT_L(n) asm volatile("s_waitcnt lgkmcnt(" #n ")" ::: "memory")
#define PG8_BAR __builtin_amdgcn_s_barrier()
#define PG8_SCHED __builtin_amdgcn_sched_barrier(0)
    Unit cur, nxt; int ui = 0;
    if (!S.next(0, cur)) return;
    f32x4 acc[2][2][4][2];
#pragma unroll
    for (int a = 0; a < 2; ++a)
#pragma unroll
        for (int b = 0; b < 2; ++b)
#pragma unroll
            for (int m = 0; m < 4; ++m)
#pragma unroll
                for (int n = 0; n < 2; ++n) acc[a][b][m][n] = (f32x4){0.f, 0.f, 0.f, 0.f};
    bf16x8 At[4][2], B0[2][2], B1[2][2];
    const char* cA = (const char*)g.A + (size_t)cur.pm * tstep; const char* cB = (const char*)g.Bt + (size_t)cur.pn * tstep;
    S.a_ready(cur);
    if constexpr (SP2) {
        PG8_STAGE(PG8_SB(0, 0), cB, voffB); PG8_STAGE(PG8_SB(0, 1), cB + hstep, voffB); PG8_STAGE(PG8_SA(0, 0), cA, voffA); PG8_STAGE(PG8_SA(0, 1), cA + hstep, voffA);
        if (wr == 1) PG8_BAR;
        PG8_WAIT_V(2); PG8_BAR;
        PG8_STAGE(PG8_SB(1, 0), cB + kstep, voffB); PG8_STAGE(PG8_SA(1, 0), cA + kstep, voffA); PG8_STAGE(PG8_SB(1, 1), cB + hstep + kstep, voffB);
        PG8_WAIT_V(6); PG8_BAR;
    } else {
        PG8_STAGE(PG8_SB(0, 0), cB, voffB); PG8_STAGE(PG8_SA(0, 0), cA, voffA); PG8_STAGE(PG8_SB(0, 1), cB + hstep, voffB); PG8_STAGE(PG8_SA(0, 1), cA + hstep, voffA);
        if (wr == 1) PG8_BAR;
        PG8_WAIT_V(4); PG8_BAR;
        PG8_STAGE(PG8_SB(1, 0), cB + kstep, voffB); PG8_STAGE(PG8_SA(1, 0), cA + kstep, voffA); PG8_STAGE(PG8_SB(1, 1), cB + hstep + kstep, voffB);
        PG8_WAIT_V(6); PG8_BAR;
    }
    for (;;) {
        const bool has_next = S.next(ui + 1, nxt);
        const char* nA = has_next ? (const char*)g.A + (size_t)nxt.pm * tstep : cA; const char* nB = has_next ? (const char*)g.Bt + (size_t)nxt.pn * tstep : cB;
        for (int t = 0; t < nt; t += 2) {
            const bool last = (t == nt - 2);
            const char* a1 = cA + (size_t)(t + 1) * kstep;
            const char* a2 = last ? nA : cA + (size_t)(t + 2) * kstep; const char* b2 = last ? nB : cB + (size_t)(t + 2) * kstep;
            const char* a3 = a2 + kstep; const char* b3 = b2 + kstep;
            if (last && has_next) S.a_ready(nxt);
            if constexpr (SP2) {
            PG8_LDB(B0, 0, 0); PG8_LDB(B1, 0, 1); PG8_SCHED; PG8_LDA(At, 0, 0); PG8_STAGE(PG8_SA(1, 1), a1 + hstep, voffA);
            PG8_WAIT_V(8); PG8_WAIT_L(0); PG8_BAR; PG8_MMA(0, 0, At, B0); PG8_MMA(0, 1, At, B1); PG8_BAR; PG8_SCHED;
            PG8_LDA(At, 0, 1); PG8_STAGE(PG8_SB(0, 0), b2, voffB); PG8_STAGE(PG8_SB(0, 1), b2 + hstep, voffB); PG8_STAGE(PG8_SA(0, 0), a2, voffA);
            PG8_WAIT_V(8); PG8_WAIT_L(0); PG8_BAR; PG8_MMA(1, 0, At, B0); PG8_MMA(1, 1, At, B1); PG8_BAR; PG8_SCHED;
            PG8_LDB(B0, 1, 0); PG8_LDB(B1, 1, 1); PG8_SCHED; PG8_LDA(At, 1, 0); PG8_STAGE(PG8_SA(0, 1), a2 + hstep, voffA);
            PG8_WAIT_V(8); PG8_WAIT_L(0); PG8_BAR; PG8_MMA(0, 0, At, B0); PG8_MMA(0, 1, At, B1); PG8_BAR; PG8_SCHED;
            PG8_LDA(At, 1, 1); PG8_STAGE(PG8_SB(1, 0), b3, voffB); PG8_STAGE(PG8_SB(1, 1), b3 + hstep, voffB); PG8_STAGE(PG8_SA(1, 0), a3, voffA);
            PG8_WAIT_V(8); PG8_WAIT_L(0); PG8_BAR; PG8_MMA(1, 0, At, B0); PG8_MMA(1, 1, At, B1); PG8_BAR; PG8_SCHED;
            } else {
            PG8_LDB(B0, 0, 0); PG8_SCHED; PG8_LDA(At, 0, 0); PG8_STAGE(PG8_SA(1, 1), a1 + hstep, voffA);
            PG8_WAIT_L(8); PG8_BAR; PG8_WAIT_L(0); PG8_MMA(0, 0, At, B0); PG8_BAR; PG8_SCHED;
            PG8_LDB(B1, 0, 1); PG8_STAGE(PG8_SB(0, 0), b2, voffB);
            PG8_BAR; PG8_WAIT_L(0); PG8_MMA(0, 1, At, B1); PG8_BAR;
            PG8_LDA(At, 0, 1); PG8_STAGE(PG8_SA(0, 0), a2, voffA);
            PG8_BAR; PG8_WAIT_L(0); PG8_MMA(1, 0, At, B0); PG8_BAR; PG8_SCHED;
            PG8_STAGE(PG8_SB(0, 1), b2 + hstep, voffB);
            PG8_WAIT_V(6); PG8_BAR; PG8_MMA(1, 1, At, B1); PG8_BAR;
            PG8_LDB(B0, 1, 0); PG8_SCHED; PG8_LDA(At, 1, 0); PG8_STAGE(PG8_SA(0, 1), a2 + hstep, voffA);
            PG8_WAIT_L(8); PG8_BAR; PG8_WAIT_L(0); PG8_MMA(0, 0, At, B0); PG8_BAR; PG8_SCHED;
            PG8_LDB(B1, 1, 1); PG8_STAGE(PG8_SB(1, 0), b3, voffB);
            PG8_BAR; PG8_WAIT_L(0); PG8_MMA(0, 1, At, B1); PG8_BAR;
            PG8_LDA(At, 1, 1); PG8_STAGE(PG8_SA(1, 0), a3, voffA);
            PG8_BAR; PG8_WAIT_L(0); PG8_MMA(1, 0, At, B0); PG8_BAR; PG8_SCHED;
            PG8_STAGE(PG8_SB(1, 1), b3 + hstep, voffB);
            PG8_WAIT_V(6); PG8_BAR; PG8_MMA(1, 1, At, B1); PG8_BAR;
            }
        }
        if constexpr (ALIGN_EPI) { if (wr == 0) PG8_BAR; }
        if constexpr (!Epi::AFTER_DRAIN) { E(acc, cur, wr, wc, fr, fq); S.done(cur); }
        if (!has_next) break;
#pragma unroll
        for (int a = 0; a < 2; ++a)
#pragma unroll
            for (int b = 0; b < 2; ++b)
#pragma unroll
                for (int m = 0; m < 4; ++m)
#pragma unroll
                    for (int n = 0; n < 2; ++n) acc[a][b][m][n] = (f32x4){0.f, 0.f, 0.f, 0.f};
        cur = nxt; cA = nA; cB = nB; ++ui;
        if constexpr (ALIGN_EPI) { if (wr == 1) PG8_BAR; }
    }
    PG8_WAIT_V(0);
    if constexpr (!ALIGN_EPI) { if (wr == 0) PG8_BAR; }
    PG8_BAR;
    if constexpr (Epi::AFTER_DRAIN) { E.fused(acc, cur, wr, wc, fr, fq, lds, wid, lane); S.done(cur); }
#undef PG8_SA
#undef PG8_SB
#undef PG8_STAGE
#undef PG8_LDA
#undef PG8_LDB
#undef PG8_MMA
#undef PG8_WAIT_V
#undef PG8_WAIT_L
#undef PG8_BAR
#undef PG8_SCHED
}
}

namespace att {
typedef unsigned short bf16_t;
typedef short bf16x8 __attribute__((ext_vector_type(8)));
typedef short s16x4 __attribute__((ext_vector_type(4)));
typedef float f32x16 __attribute__((ext_vector_type(16)));
typedef float f32x4 __attribute__((ext_vector_type(4)));
typedef unsigned u32x4 __attribute__((ext_vector_type(4)));
constexpr int NW = 8, QBLK = 32, KVBLK = 64, QB = NW * QBLK;
constexpr float THRL = 8.f;
#define SBAR() __builtin_amdgcn_sched_barrier(0)
__device__ __forceinline__ int crow(int r, int hi) { return (r & 3) + 8 * (r >> 2) + 4 * hi; }
__device__ __forceinline__ unsigned cvtpk(float lo, float hi) { unsigned r; asm volatile("v_cvt_pk_bf16_f32 %0, %1, %2" : "=v"(r) : "v"(lo), "v"(hi)); return r; }
__device__ __forceinline__ int v_rd_base(int lane) { return ((lane & 3) << 3) | (((lane >> 2) & 3) << 6) | (((lane >> 4) & 1) << 5) | (((lane >> 5) & 1) << 8); }
__device__ __forceinline__ void mask_tile(f32x16& p0, f32x16& p1, int dq, unsigned W) {
    const float NEG = -__builtin_inff();
#pragma unroll
    for (int r = 0; r < 16; ++r) { const int c = (r & 3) + 8 * (r >> 2);
        if ((unsigned)(dq - c) >= W) p0[r] = NEG;
        if ((unsigned)(dq - c - 32) >= W) p1[r] = NEG; }
}
__device__ __forceinline__ void bias_tile(f32x16& p0, f32x16& p1, int dq, const float* tb) {
#pragma unroll
    for (int r = 0; r < 16; ++r) { const int c = (r & 3) + 8 * (r >> 2);
        p0[r] += tb[(dq - c) & 255];
        p1[r] += tb[(dq - c - 32) & 255]; }
}
__device__ __forceinline__ void partialSM(f32x16& p0, f32x16& p1, float& m_reg, float& mn, float& alpha) {
    float pmax = p0[0];
#pragma unroll
    for (int r = 1; r < 16; ++r) pmax = fmaxf(pmax, p0[r]);
#pragma unroll
    for (int r = 0; r < 16; ++r) pmax = fmaxf(pmax, p1[r]);
    { auto rr = __builtin_amdgcn_permlane32_swap(__float_as_uint(pmax), __float_as_uint(pmax), false, false);
      pmax = fmaxf(__uint_as_float(rr[0]), __uint_as_float(rr[1])); }
    if (__builtin_expect(__all((pmax - m_reg) <= THRL), 1)) { mn = m_reg; alpha = 1.f; }
    else { mn = fmaxf(m_reg, pmax); alpha = __builtin_amdgcn_exp2f(m_reg - mn); m_reg = mn; }
#pragma unroll
    for (int r = 0; r < 16; ++r) p0[r] -= mn;
#pragma unroll
    for (int r = 0; r < 16; ++r) p1[r] -= mn;
#pragma unroll
    for (int r = 0; r < 16; ++r) p0[r] = __builtin_amdgcn_exp2f(p0[r]);
}
__device__ __forceinline__ void finishSM(f32x16& p0, f32x16& p1, float alpha, float& l_reg, bf16x8& pa0, bf16x8& pa1, bf16x8& pa2, bf16x8& pa3) {
#pragma unroll
    for (int r = 0; r < 16; ++r) p1[r] = __builtin_amdgcn_exp2f(p1[r]);
    float ps = 0;
#pragma unroll
    for (int r = 0; r < 16; ++r) ps += p0[r];
#pragma unroll
    for (int r = 0; r < 16; ++r) ps += p1[r];
    { auto rr = __builtin_amdgcn_permlane32_swap(__float_as_uint(ps), __float_as_uint(ps), false, false);
      ps = __uint_as_float(rr[0]) + __uint_as_float(rr[1]); }
    l_reg = l_reg * alpha + ps;
#define PK4(P, B_, OUT) do { unsigned a0 = cvtpk(P[B_+0], P[B_+1]), a1 = cvtpk(P[B_+2], P[B_+3]);                          \
        unsigned b0 = cvtpk(P[B_+4], P[B_+5]), b1 = cvtpk(P[B_+6], P[B_+7]);                                             \
        auto r0 = __builtin_amdgcn_permlane32_swap(a0, b0, false, false); auto r1 = __builtin_amdgcn_permlane32_swap(a1, b1, false, false); \
        u32x4 w = {r0[0], r1[0], r0[1], r1[1]}; OUT = *reinterpret_cast<bf16x8*>(&w); } while (0)
    PK4(p0, 0, pa0); PK4(p0, 8, pa1); PK4(p1, 0, pa2); PK4(p1, 8, pa3);
#undef PK4
}

template <int DQK, int DV, int LDQ, int LDK, int LDV, int LDO, bool SWA, int NQR>
struct Body {
    static constexpr int KROW = DQK * 2, SHM_K = KVBLK * KROW, SHM_V = KVBLK * DV * 2, NCB = DV / 32, KS_STR = 2 * NCB * 512, HF_STR = NCB * 512;
    static constexpr int ND = DQK / 16, NKP = (DQK == 192) ? 3 : 1, NVP = DV / 64, NDV = DV / 32;
    static constexpr int OFF_V = 0, OFF_K = 2 * SHM_V, OFF_WS = OFF_K + 2 * SHM_K, OFF_TBL = OFF_WS + NW * 64 * 4, OFF_QL = OFF_TBL + 2048, NQL_LDS = DQK / 16 - NQR, QL_WAVE = QBLK * NQL_LDS * 32, LDS_BYTES = OFF_QL + NW * QL_WAVE;
    static constexpr bool SK = SWA;
    static_assert((DQK == 192 || DQK == 64) && (DV == 128 || DV == 64), "geometry");
    struct Ref { const bf16_t* Q; const bf16_t* K; const bf16_t* V; bf16_t* O; int P0; const float* bias; float sink; };
    struct Seam { bf16x8 qr[NQR]; bf16x8 st_k[NKP]; bf16x8 st_v[NVP]; };

    static __device__ __forceinline__ int kswz(int row, int colB) { return row * KROW + (colB ^ ((row & 7) << 4)); }
    static __device__ __forceinline__ int v_st(int k, int c) { const int kk = (k & ~0xC) | ((k & 4) << 1) | ((k & 8) >> 1); return ((kk >> 3) * NCB + (c >> 5)) * 512 + ((kk & 7) * 32 + (c & 31)) * 2; }
    static __device__ __forceinline__ void kpiece(int tid, int p, int& row, int& col) {
        if (DQK == 192) { if (p < 2) { row = (tid >> 4) + 32 * p; col = (tid & 15) * 8; } else { row = tid >> 3; col = 128 + (tid & 7) * 8; } }
        else { row = tid >> 3; col = (tid & 7) * 8; }
    }
    static __device__ __forceinline__ void vpiece(int tid, int p, int& row, int& col) {
        if (DV == 128) { row = (tid >> 4) + 32 * p; col = (tid & 15) * 8; } else { row = tid >> 3; col = (tid & 7) * 8; }
    }
    static __device__ __forceinline__ int swa_jlo(int P0, int W) { const int lowk = P0 - W + 1; return lowk > 0 ? lowk / KVBLK : 0; }

    template <int KB>
    static __device__ __forceinline__ void qkt(f32x16& p0, f32x16& p1, const char* K_lds, int r32, int hi, const bf16x8* qr, const char* qlw, bool act) {
        if (SK && !act) { const float NEG = -__builtin_inff();
#pragma unroll
            for (int r = 0; r < 16; ++r) { p0[r] = NEG; p1[r] = NEG; } return; }
        p0 = f32x16{}; p1 = f32x16{};
        const char* kb[4];
#pragma unroll
        for (int dd = 0; dd < 4; ++dd) kb[dd] = K_lds + KB * SHM_K + kswz(r32, (dd * 16 + hi * 8) * 2);
        constexpr int PD = (ND < 4) ? ND : 4;
        bf16x8 rk0[PD], rk1[PD], rq[PD];
#define QK_LOAD(d0_, s_) do { const char* a_ = kb[(d0_) & 3] + ((d0_) >> 2) * 128; \
            rk0[s_] = *reinterpret_cast<const bf16x8*>(a_); rk1[s_] = *reinterpret_cast<const bf16x8*>(a_ + 32 * KROW); \
            if ((d0_) >= NQR) rq[s_] = *reinterpret_cast<const bf16x8*>(qlw + (((2 * ((d0_) - NQR) + hi) * 16) ^ ((r32 & 7) << 4))); } while (0)
#pragma unroll
        for (int d0 = 0; d0 < PD; ++d0) QK_LOAD(d0, d0);
#pragma unroll
        for (int d0 = 0; d0 < ND; ++d0) {
            SBAR();
            const bf16x8 qf = (d0 < NQR) ? qr[d0 < NQR ? d0 : 0] : rq[d0 % PD];
            p0 = __builtin_amdgcn_mfma_f32_32x32x16_bf16(rk0[d0 % PD], qf, p0, 0, 0, 0);
            p1 = __builtin_amdgcn_mfma_f32_32x32x16_bf16(rk1[d0 % PD], qf, p1, 0, 0, 0);
            SBAR();
            if (d0 + PD < ND) QK_LOAD(d0 + PD, d0 % PD);
        }
#undef QK_LOAD
    }
    template <int VB>
    static __device__ __forceinline__ void pv_tile(f32x16* o, int vb0, bf16x8 pa0, bf16x8 pa1, bf16x8 pa2, bf16x8 pa3, bool act) {
        if (SK && !act) return;
#define TRRD(dst, off) asm volatile("ds_read_b64_tr_b16 %0, %1 offset:%2" : "=&v"(dst) : "v"(vb0), "i"(off) : "memory")
#define PV_RD(d0, L, H) do { constexpr int b_ = VB * SHM_V + (d0) * 512; \
        TRRD(L[0], b_); TRRD(H[0], b_ + HF_STR); TRRD(L[1], b_ + KS_STR); TRRD(H[1], b_ + KS_STR + HF_STR); TRRD(L[2], b_ + 2 * KS_STR); TRRD(H[2], b_ + 2 * KS_STR + HF_STR); TRRD(L[3], b_ + 3 * KS_STR); TRRD(H[3], b_ + 3 * KS_STR + HF_STR); } while (0)
#define PV_MM(d0, L, H) do { \
        o[d0] = __builtin_amdgcn_mfma_f32_32x32x16_bf16(pa0, (bf16x8){L[0][0], L[0][1], L[0][2], L[0][3], H[0][0], H[0][1], H[0][2], H[0][3]}, o[d0], 0, 0, 0);   \
        o[d0] = __builtin_amdgcn_mfma_f32_32x32x16_bf16(pa1, (bf16x8){L[1][0], L[1][1], L[1][2], L[1][3], H[1][0], H[1][1], H[1][2], H[1][3]}, o[d0], 0, 0, 0);   \
        o[d0] = __builtin_amdgcn_mfma_f32_32x32x16_bf16(pa2, (bf16x8){L[2][0], L[2][1], L[2][2], L[2][3], H[2][0], H[2][1], H[2][2], H[2][3]}, o[d0], 0, 0, 0);   \
        o[d0] = __builtin_amdgcn_mfma_f32_32x32x16_bf16(pa3, (bf16x8){L[3][0], L[3][1], L[3][2], L[3][3], H[3][0], H[3][1], H[3][2], H[3][3]}, o[d0], 0, 0, 0); } while (0)
#define LGK_WAIT(n) do { asm volatile("s_waitcnt lgkmcnt(%0)" :: "i"(n) : "memory"); SBAR(); } while (0)
        s16x4 la[4], ha[4], lb[4], hb[4];
        SBAR();
        PV_RD(0, la, ha); PV_RD(1, lb, hb); LGK_WAIT(8); PV_MM(0, la, ha); SBAR();
        if constexpr (NDV == 4) {
            PV_RD(2, la, ha); LGK_WAIT(8); PV_MM(1, lb, hb); SBAR();
            PV_RD(3, lb, hb); LGK_WAIT(8); PV_MM(2, la, ha); SBAR();
            LGK_WAIT(0); PV_MM(3, lb, hb);
        } else {
            LGK_WAIT(0); PV_MM(1, lb, hb);
        }
        SBAR();
#undef LGK_WAIT
#undef PV_MM
#undef PV_RD
#undef TRRD
    }

#define VMW() asm volatile("s_waitcnt vmcnt(0)" ::: "memory")
#define VMWN(n) asm volatile("s_waitcnt vmcnt(%0)" :: "i"(n) : "memory")
#define SLOAD_H(Kp, Vp, k0) do { \
        _Pragma("unroll") for (int p_ = 0; p_ < NVP; ++p_) { int rr_, cc_; vpiece(tid, p_, rr_, cc_); S.st_v[p_] = *reinterpret_cast<const bf16x8*>((Vp) + (unsigned)(((k0) + rr_) * LDV + cc_)); } \
        _Pragma("unroll") for (int p_ = 0; p_ < NKP; ++p_) { int rr_, cc_; kpiece(tid, p_, rr_, cc_); S.st_k[p_] = *reinterpret_cast<const bf16x8*>((Kp) + (unsigned)(((k0) + rr_) * LDK + cc_)); } } while (0)
#define SWRITE_HK(bf) do { _Pragma("unroll") for (int p_ = 0; p_ < NKP; ++p_) { int rr_, cc_; kpiece(tid, p_, rr_, cc_); *(bf16x8*)(K_lds + (bf) * SHM_K + kswz(rr_, cc_ * 2)) = S.st_k[p_]; } } while (0)
#define SWRITE_HV(bf) do { _Pragma("unroll") for (int p_ = 0; p_ < NVP; ++p_) { int rr_, cc_; vpiece(tid, p_, rr_, cc_); *(bf16x8*)(V_lds + (bf) * SHM_V + v_st(rr_, cc_)) = S.st_v[p_]; } } while (0)
#define SWRITE_H(bf) do { SWRITE_HV(bf); SWRITE_HK(bf); } while (0)
#define QLOAD(ref) do { _Pragma("unroll") for (int d0 = 0; d0 < NQR; ++d0) S.qr[d0] = *reinterpret_cast<const bf16x8*>((ref).Q + (size_t)(wid * QBLK + r32) * LDQ + d0 * 16 + hi * 8); } while (0)
#define QLDS_FILL(ref) do { if constexpr (NQL_LDS > 0) { bf16x8 t_[NQL_LDS]; \
        _Pragma("unroll") for (int e_ = 0; e_ < NQL_LDS; ++e_) t_[e_] = *reinterpret_cast<const bf16x8*>((ref).Q + (size_t)(wid * QBLK + r32) * LDQ + (NQR + e_) * 16 + hi * 8); \
        _Pragma("unroll") for (int e_ = 0; e_ < NQL_LDS; ++e_) *(bf16x8*)(lds + OFF_QL + wid * QL_WAVE + r32 * (NQL_LDS * 32) + (((2 * e_ + hi) * 16) ^ ((r32 & 7) << 4))) = t_[e_]; \
        asm volatile("s_waitcnt lgkmcnt(0)" ::: "memory"); } } while (0)

    static __device__ __forceinline__ void block(const Ref& cur, int skv, int W, char* lds, const int wid) {
        int lane_v; asm volatile("v_mbcnt_lo_u32_b32 %0, -1, 0\n\tv_mbcnt_hi_u32_b32 %0, -1, %0" : "=v"(lane_v));
        const int lane = lane_v, tid = wid * 64 + lane, r32 = lane & 31, hi = lane >> 5;
        Seam S;
        const int j_lo = swa_jlo(cur.P0, W);
        int j_hi = (cur.P0 + QB - 1) / KVBLK + 1; if (j_hi > skv / KVBLK) j_hi = skv / KVBLK;
        const int NT = j_hi - j_lo;
        const int qlo = cur.P0 + wid * QBLK, qm = qlo + r32 - 4 * hi;
        char* V_lds = lds + OFF_V; char* K_lds = lds + OFF_K;
        float* ws = (float*)(lds + OFF_WS) + wid * 64; float* li_l = ws, * al_l = ws + 32;
        const float* tb = (const float*)(lds + OFF_TBL);
        const char* qlw = lds + OFF_QL + wid * QL_WAVE + r32 * (NQL_LDS * 32);
        float m_reg = SWA ? cur.sink : -1e30f, l_reg = SWA ? 1.f : 0.f; f32x16 o[NDV];
#pragma unroll
        for (int d_ = 0; d_ < NDV; ++d_) o[d_] = f32x16{};
        const int vb0 = (int)(uintptr_t)V_lds + v_rd_base(lane);
        const bf16_t* Kh = cur.K; const bf16_t* Vh = cur.V;
#define KBASE(t) ((j_lo + (t)) * KVBLK)
#define ACT(t) (KBASE(t) <= qlo + QBLK - 1 && KBASE(t) + KVBLK - 1 >= qlo - W + 1)
        QLOAD(cur); QLDS_FILL(cur);
        if (SWA) { if (tid < 256) ((float*)(lds + OFF_TBL))[tid] = tid < 128 ? cur.bias[tid] : 0.f; }
        SLOAD_H(Kh, Vh, KBASE(0)); VMW(); SWRITE_H(0);
        const int grp = wid >> 2;
        if (grp == 1 && NT > 1) { SLOAD_H(Kh, Vh, KBASE(1)); }
        __syncthreads();
        if (grp == 1) __syncthreads();
        for (int t = 0; t < NT; ++t) {
            const int bo = t & 1;
            f32x16 p0, p1; float mn, alpha; bf16x8 pa0, pa1, pa2, pa3;
            const bool act = ACT(t);
            if (grp == 0 && t + 1 < NT) { SLOAD_H(Kh, Vh, KBASE(t + 1)); }
            SBAR();
            if (bo == 0) qkt<0>(p0, p1, K_lds, r32, hi, S.qr, qlw, act); else qkt<1>(p0, p1, K_lds, r32, hi, S.qr, qlw, act);
            SBAR();
            if (grp == 1 && t + 1 < NT) { VMW(); if (bo == 0) { SWRITE_H(1); } else { SWRITE_H(0); } }
            __syncthreads();
            if (grp == 1 && t + 2 < NT) { SLOAD_H(Kh, Vh, KBASE(t + 2)); }
            SBAR();
            { const int kb_ = KBASE(t);
              if (!SK || act) { if (SWA) bias_tile(p0, p1, qm - kb_, tb);
                  if (kb_ + KVBLK - 1 > qlo || kb_ <= qlo + QBLK - 1 - W) mask_tile(p0, p1, qm - kb_, (unsigned)W); } }
            partialSM(p0, p1, m_reg, mn, alpha);
            if (__any(alpha < 1.f)) { if (hi == 0) al_l[r32] = alpha; asm volatile("s_waitcnt lgkmcnt(0)" ::: "memory");
#pragma unroll
                for (int d_ = 0; d_ < NDV; ++d_)
#pragma unroll
                    for (int r = 0; r < 16; ++r) o[d_][r] *= al_l[crow(r, hi)]; }
            finishSM(p0, p1, alpha, l_reg, pa0, pa1, pa2, pa3); SBAR();
            if (bo == 0) pv_tile<0>(o, vb0, pa0, pa1, pa2, pa3, act); else pv_tile<1>(o, vb0, pa0, pa1, pa2, pa3, act);
            SBAR();
            if (grp == 0 && t + 1 < NT) { VMW(); if (bo == 0) { SWRITE_H(1); } else { SWRITE_H(0); } }
            __syncthreads();
        }
        if (grp == 0) __syncthreads();
        if (hi == 0) li_l[r32] = l_reg; asm volatile("s_waitcnt lgkmcnt(0)" ::: "memory");
        float rli[16];
#pragma unroll
        for (int r = 0; r < 16; ++r) rli[r] = __builtin_amdgcn_rcpf(li_l[crow(r, hi)]);
        bf16_t* Ow = cur.O + (size_t)(wid * QBLK) * LDO;
#pragma unroll
        for (int r = 0; r < 16; ++r) { const int orow = crow(r, hi);
#pragma unroll
            for (int d0 = 0; d0 < NDV; ++d0) { const float v = o[d0][r] * rli[r];
                const float vn = __shfl_xor(v, 1);
                if ((r32 & 1) == 0) *(unsigned*)(Ow + (size_t)orow * LDO + d0 * 32 + r32) = cvtpk(v, vn); } }
        __syncthreads();
#undef KBASE
#undef ACT
    }
#undef VMW
#undef VMWN
#undef SLOAD_H
#undef SWRITE_HK
#undef SWRITE_HV
#undef SWRITE_H
#undef QLOAD
#undef QLDS_FILL
};
#undef SBAR
}

constexpr int NWAVES = 8;
constexpr int BATCH = 2, SEQ = 16384, DM = 1024, MTOK = BATCH * SEQ;
constexpr int IN_COLS = 1216, IN_N = 1280, QB_N = 768, KVB_N = 1024, QL = 256, KVL = 128, DFF = 2816, UP_N = 5632;
constexpr float LOG2E_F = 1.4426950408889634f;
#ifndef PROBE_MLA_REPS
#define PROBE_MLA_REPS 1
#endif
#ifndef PROBE_SWA_REPS
#define PROBE_SWA_REPS 1
#endif
#ifndef UP_ALIGN
#define UP_ALIGN true
#endif
#ifndef MLA_NQR
#define MLA_NQR 4
#endif

constexpr size_t MiB = 1u << 20;
constexpr size_t WS_CTL = 0, CTL_ZERO_BYTES = 1 * MiB;
constexpr size_t WS_BIAS = 1 * MiB;
constexpr size_t WS_WIN = 2 * MiB, WS_WQB = 5 * MiB, WS_WKVB = 6 * MiB, WS_WOUT = 7 * MiB, WS_WUP = 9 * MiB, WS_WDOWN = 20 * MiB;
constexpr size_t WS_CS = 26 * MiB;
constexpr size_t WS_H0 = 34 * MiB;
constexpr size_t WS_QA = 98 * MiB, WS_KA = 130 * MiB, WS_VA = 138 * MiB, WS_CQ = 146 * MiB, WS_CKV = 162 * MiB, WS_QB = 170 * MiB, WS_KB = 218 * MiB, WS_VB = 266 * MiB, WS_MIX = 298 * MiB;
constexpr size_t WS_ACT = 98 * MiB;
constexpr size_t WS_U = 274 * MiB;
constexpr size_t WS_EDGE = 274 * MiB;
constexpr size_t WS_END = 450 * MiB;

constexpr int RING_BYTES = 131072, LDS_BYTES = 163840;

#define GAS __attribute__((address_space(1)))
#define LAS __attribute__((address_space(3)))
typedef unsigned short bf16;
typedef unsigned v4u __attribute__((ext_vector_type(4)));
typedef unsigned v2u __attribute__((ext_vector_type(2)));
typedef float f32x4 __attribute__((ext_vector_type(4)));
#define LDS_WAIT() asm volatile("s_waitcnt lgkmcnt(0)" ::: "memory")
__device__ __forceinline__ unsigned f2bf(float f) { unsigned u = __builtin_bit_cast(unsigned, f); return (u + 0x7fffu + ((u >> 16) & 1u)) >> 16; }
__device__ __forceinline__ unsigned pk2(float lo, float hi) { return f2bf(lo) | (f2bf(hi) << 16); }
__device__ __forceinline__ float bf2f(unsigned short b) { return __builtin_bit_cast(float, (unsigned)b << 16); }
__device__ __forceinline__ float wave_sum(float v) {
#pragma unroll
    for (int o = 1; o < 64; o <<= 1) v += __shfl_xor(v, o);
    return v;
}

typedef GAS unsigned gu32;
#define RLX_AGENT __ATOMIC_RELAXED, __HIP_MEMORY_SCOPE_AGENT
constexpr size_t WS_BAR = 768 * 1024;
constexpr int MISC_OFF = 163840 - 64;
#define XB_TMO      128
#define XB_XCNT(j)  (256  + 64 * (j))
#define XB_XSUB(j)  (1280 + 64 * (j))
#define XB_XGEN(j)  (2304 + 64 * (j))
#define XB_TOP      3328
#define XB_TOPGEN   3392
#define XCD_BAR_WORDS 3456
#define XB_SPIN_CAP (1u << 18)

__device__ __forceinline__ unsigned xb_ld(unsigned* p)              { return __hip_atomic_load(p, __ATOMIC_RELAXED, __HIP_MEMORY_SCOPE_AGENT); }
__device__ __forceinline__ unsigned xb_add(unsigned* p, unsigned v) { return __hip_atomic_fetch_add(p, v, __ATOMIC_RELAXED, __HIP_MEMORY_SCOPE_AGENT); }
__device__ __forceinline__ unsigned xb_xcc_id() { return (unsigned)__builtin_amdgcn_s_getreg((3 << 11) | 20) & 0xFu; }
#define XB_SPIN(cond, bar) do { unsigned _sp = 0; while (cond) { __builtin_amdgcn_s_sleep(1); \
    if ((++_sp & 255u) == 0u) { if (xb_ld(&(bar)[XB_TMO])) break; if (_sp > XB_SPIN_CAP) { atomicAdd(&(bar)[XB_TMO], 1u); break; } } } } while (0)

struct XcdBarrier {
    unsigned* bar; unsigned x;
    volatile LAS unsigned* st;
};

__device__ __forceinline__ XcdBarrier xcd_barrier_post(unsigned* bar, volatile LAS unsigned* st, bool leader) {
    XcdBarrier b; b.bar = bar; b.x = xb_xcc_id(); b.st = st;
    if (leader) (void)xb_add(&bar[XB_XCNT(b.x)], 1u);
    return b;
}
__device__ __forceinline__ void xcd_barrier_complete(unsigned* bar, unsigned x, unsigned& nloc, unsigned& nx) {
    const unsigned G = gridDim.x * gridDim.y * gridDim.z;
    unsigned sum, cnt, mine, sp = 0u;
    for (;;) {
        sum = 0u; cnt = 0u; mine = 0u;
#pragma unroll
        for (unsigned j = 0; j < 16; ++j) { const unsigned c = xb_ld(&bar[XB_XCNT(j)]); sum += c; cnt += (c > 0u) ? 1u : 0u; mine = (j == x) ? c : mine; }
        if (sum == G) break;
        __builtin_amdgcn_s_sleep(1);
        if ((++sp & 255u) == 0u) { if (xb_ld(&bar[XB_TMO])) break; if (sp > XB_SPIN_CAP) { atomicAdd(&bar[XB_TMO], 1u); break; } }
    }
    nloc = mine > 0u ? mine : 1u; nx = cnt > 0u ? cnt : 1u;
}

__device__ __forceinline__ void xcd_barrier(const XcdBarrier& b, bool leader) {
    asm volatile("s_waitcnt vmcnt(0)" ::: "memory");
    __syncthreads();
    if (leader) {
        unsigned* bar = b.bar;
        __builtin_amdgcn_s_waitcnt(0);
        unsigned nloc = b.st[0], nx = b.st[1];
        if (nloc == 0u) { xcd_barrier_complete(bar, b.x, nloc, nx); b.st[0] = nloc; b.st[1] = nx; }
        const unsigned old = xb_add(&bar[XB_XSUB(b.x)], 1u);
        const unsigned gen = old / nloc;
        if (old + 1u == (gen + 1u) * nloc) {
            __builtin_amdgcn_fence(__ATOMIC_RELEASE, "agent");
            asm volatile("s_waitcnt vmcnt(0)" ::: "memory");
            const unsigned og = xb_add(&bar[XB_TOP], 1u);
            const unsigned tg = og / nx;
            if (og + 1u == (tg + 1u) * nx) xb_add(&bar[XB_TOPGEN], 1u);
            else XB_SPIN(xb_ld(&bar[XB_TOPGEN]) == tg, bar);
            __builtin_amdgcn_fence(__ATOMIC_ACQUIRE, "agent");
            xb_add(&bar[XB_XGEN(b.x)], 1u);
            asm volatile("s_waitcnt vmcnt(0)" ::: "memory");
        } else {
            XB_SPIN(xb_ld(&bar[XB_XGEN(b.x)]) == gen, bar);
            __builtin_amdgcn_fence(__ATOMIC_ACQUIRE, "agent");
            asm volatile("s_waitcnt vmcnt(0)" ::: "memory");
        }
    }
    __syncthreads();
}

struct Args { const float* in[19]; const int* pos; float* out; unsigned char* ws; };

__device__ __forceinline__ int dst_row(int mode, int n) {
    if (mode == 1) {
        if (n < 1152) return n; const int e = n - 1152, d = e & 31, hf = e >> 5; return 1152 + 8 * (d >> 2) + 4 * hf + (d & 3);
    } else if (mode == 2) {
        const int h = n / 192, e = n - h * 192; if (e < 128) return 128 * h + e; const int ee = e - 128, d = ee & 31, hf = ee >> 5; return 512 + 64 * h + 8 * (d >> 2) + 4 * hf + (d & 3);
    } else if (mode == 3) {
        if (n < DFF) return 256 * (n >> 7) + (n & 127); const int v = n - DFF; return 256 * (v >> 7) + 128 + (v & 127);
    }
    return n;
}
__device__ __forceinline__ void p0_transpose_item(const float* W, int K, int N, const float* gk, bf16* WT, int mode, LAS float* scr, int item, int lane) {
    const int nblk = N / 32, kb = item / nblk, nb = item % nblk, k0 = 64 * kb, n0 = 32 * nb;
#pragma unroll 8
    for (int i = 0; i < 32; ++i) { const int kk = 2 * i + (lane >> 5); float w = W[(size_t)(k0 + kk) * N + n0 + (lane & 31)]; if (gk) w *= gk[k0 + kk]; scr[kk * 33 + (lane & 31)] = w; }
    LDS_WAIT(); asm volatile("" ::: "memory");
    const int c = lane & 7;
#pragma unroll
    for (int j = 0; j < 4; ++j) { const int n = (lane >> 3) + 8 * j; const LAS float* s = scr + (8 * c) * 33 + n;
        v4u o; o.x = pk2(s[0 * 33], s[1 * 33]); o.y = pk2(s[2 * 33], s[3 * 33]); o.z = pk2(s[4 * 33], s[5 * 33]); o.w = pk2(s[6 * 33], s[7 * 33]);
        *(GAS v4u*)(WT + (size_t)dst_row(mode, n0 + n) * K + k0 + 8 * c) = o; }
    LDS_WAIT(); asm volatile("" ::: "memory");
}
__device__ __forceinline__ void rms_row_to_bf16(const float* xrow, const float* g, bf16* orow, int lane) {
    const GAS f32x4* xr = (const GAS f32x4*)xrow + lane; const GAS f32x4* gr = (const GAS f32x4*)g + lane;
    f32x4 v[4]; float s = 0.f;
#pragma unroll
    for (int j = 0; j < 4; ++j) { v[j] = xr[64 * j]; s += (v[j].x * v[j].x + v[j].y * v[j].y) + (v[j].z * v[j].z + v[j].w * v[j].w); }
    const float rstd = 1.f / sqrtf(wave_sum(s) * (1.f / DM) + 1e-6f);
    GAS unsigned long long* o8 = (GAS unsigned long long*)orow + lane;
#pragma unroll
    for (int j = 0; j < 4; ++j) { const f32x4 gg = gr[64 * j];
        o8[64 * j] = (unsigned long long)pk2(v[j].x * rstd * gg.x, v[j].y * rstd * gg.y) | ((unsigned long long)pk2(v[j].z * rstd * gg.z, v[j].w * rstd * gg.w) << 32); }
}
__device__ __forceinline__ int t5_bucket(int n) {
    if (n < 16) return n;
    int l = 16 + (int)(logf((float)n / 16.0f) / 2.0794415416798357f * 16.0f); return l < 31 ? l : 31;
}

typedef const __attribute__((address_space(4))) Args* KArgs;
__device__ __forceinline__ KArgs kargs_now() { KArgs p = (KArgs)__builtin_amdgcn_kernarg_segment_ptr(); asm volatile("" : "+s"(p)); return p; }
#define PTRS() KArgs A_ = kargs_now(); unsigned char* ws = A_->ws; (void)ws
#define SSQ_Q ((float*)(ws + WS_CTL))
#define SSQ_KV (SSQ_Q + MTOK)
#define SSQ2 (SSQ_Q + 2 * MTOK)
#define SSQ3 (SSQ_Q + 3 * MTOK)
#define P_BIAS2 ((float*)(ws + WS_BIAS))
#define P_W_IN_T ((bf16*)(ws + WS_WIN))
#define P_W_QB_T ((bf16*)(ws + WS_WQB))
#define P_W_KVB_T ((bf16*)(ws + WS_WKVB))
#define P_W_OUT_T ((bf16*)(ws + WS_WOUT))
#define P_W_UP_T ((bf16*)(ws + WS_WUP))
#define P_W_DOWN_T ((bf16*)(ws + WS_WDOWN))
#define P_CS ((float*)(ws + WS_CS))
#define P_H0 ((bf16*)(ws + WS_H0))
#define P_QA ((bf16*)(ws + WS_QA))
#define P_KA ((bf16*)(ws + WS_KA))
#define P_VA ((bf16*)(ws + WS_VA))
#define P_CQ ((bf16*)(ws + WS_CQ))
#define P_CKV ((bf16*)(ws + WS_CKV))
#define P_QB ((bf16*)(ws + WS_QB))
#define P_KB ((bf16*)(ws + WS_KB))
#define P_VB ((bf16*)(ws + WS_VB))
#define P_MIX ((bf16*)(ws + WS_MIX))
#define P_ACT ((bf16*)(ws + WS_ACT))
#define P_U ((bf16*)(ws + WS_U))
#define P_EDGE ((float*)(ws + WS_EDGE))

__global__ void __launch_bounds__(NWAVES * 64, 2) hymba_fwd(Args args) {
    extern __shared__ __attribute__((aligned(16))) unsigned char lds[];
    const int wave = __builtin_amdgcn_readfirstlane(threadIdx.x >> 6);
#define LANE_NOW(var) int var; asm volatile("v_mbcnt_lo_u32_b32 %0, -1, 0\n\tv_mbcnt_hi_u32_b32 %0, -1, %0" : "=v"(var))
    { LANE_NOW(l0_); if (wave == 0 && l0_ < 16) ((volatile LAS unsigned*)((LAS unsigned char*)lds + MISC_OFF))[l0_] = 0u; }
    __syncthreads();
#define GEO() int G = gridDim.x; asm volatile("" : "+s"(G)); int bx = blockIdx.x; asm volatile("" : "+s"(bx)); \
    const int vcu = (G % 8 == 0) ? (bx % 8) * (G / 8) + bx / 8 : bx, gw = vcu * NWAVES + wave, NGW = G * NWAVES, NGT = NGW * 64; (void)gw; (void)NGW; (void)NGT; (void)vcu
#define MK_XBAR(xb_) XcdBarrier xb_; { KArgs Ab_ = kargs_now(); xb_.bar = (unsigned*)(Ab_->ws + WS_BAR); xb_.x = xb_xcc_id(); xb_.st = (volatile LAS unsigned*)((LAS unsigned char*)lds + MISC_OFF); }
    { MK_XBAR(xb0_); LANE_NOW(l0_); if (wave == 0 && l0_ == 0) (void)xb_add(&xb0_.bar[XB_XCNT(xb0_.x)], 1u); }
#define GRID_BAR() do { MK_XBAR(xbb_); LANE_NOW(lb_); xcd_barrier(xbb_, wave == 0 && lb_ == 0); } while (0)

#ifndef NO_P0
    {   GEO();
    {
        PTRS(); const float* x = A_->in[0]; const float* rel_bias = A_->in[2]; const float* attn_g = A_->in[3]; const float* w_in = A_->in[4];
        const float* q_norm_g = A_->in[6]; const float* w_q_b = A_->in[7]; const float* kv_norm_g = A_->in[8]; const float* w_kv_b = A_->in[9]; const float* w_out = A_->in[12];
        const float* ffn_g = A_->in[13]; const float* w_up = A_->in[14]; const float* w_down = A_->in[17]; const int* pos = A_->pos;
        bf16* W_IN_T = P_W_IN_T; bf16* W_QB_T = P_W_QB_T; bf16* W_KVB_T = P_W_KVB_T; bf16* W_OUT_T = P_W_OUT_T; bf16* W_UP_T = P_W_UP_T; bf16* W_DOWN_T = P_W_DOWN_T; bf16* H0 = P_H0; float* CS = P_CS; float* bias2 = P_BIAS2;
        LANE_NOW(lane); const int gt = gw * 64 + lane;
        LAS float* scr = (LAS float*)((LAS unsigned char*)lds + wave * 16384);
        constexpr int I_IN = (DM / 64) * (IN_COLS / 32), I_QB = (QL / 64) * (QB_N / 32), I_KVB = (KVL / 64) * (KVB_N / 32), I_OUT = (DM / 64) * (DM / 32),
                      I_UP = (DM / 64) * (UP_N / 32), I_DOWN = (DFF / 64) * (DM / 32);
        constexpr int NITEMS = I_IN + I_QB + I_KVB + I_OUT + I_UP + I_DOWN;
        for (int it = gw; it < NITEMS; it += NGW) {
            int r = it;
            if (r < I_IN) { p0_transpose_item(w_in, DM, IN_COLS, nullptr, W_IN_T, 1, scr, r, lane); continue; } r -= I_IN;
            if (r < I_QB) { p0_transpose_item(w_q_b, QL, QB_N, q_norm_g, W_QB_T, 2, scr, r, lane); continue; } r -= I_QB;
            if (r < I_KVB) { p0_transpose_item(w_kv_b, KVL, KVB_N, kv_norm_g, W_KVB_T, 0, scr, r, lane); continue; } r -= I_KVB;
            if (r < I_OUT) { p0_transpose_item(w_out, DM, DM, nullptr, W_OUT_T, 0, scr, r, lane); continue; } r -= I_OUT;
            if (r < I_UP) { p0_transpose_item(w_up, DM, UP_N, ffn_g, W_UP_T, 3, scr, r, lane); continue; } r -= I_UP;
            p0_transpose_item(w_down, DFF, DM, nullptr, W_DOWN_T, 0, scr, r, lane);
        }
        for (int i = gt; i < (IN_N - IN_COLS) * DM / 8; i += NGT) ((GAS v4u*)(W_IN_T + (size_t)IN_COLS * DM))[i] = (v4u){0u, 0u, 0u, 0u};
        for (int m = gw; m < MTOK; m += NGW) rms_row_to_bf16(x + (size_t)m * DM, attn_g, H0 + (size_t)m * DM, lane);
        for (int i = gt; i < MTOK * 32; i += NGT) { const int t = i >> 5, d = i & 31;
            const float inv_freq = exp2f(-(float)d * (13.287712379549449f / 32.0f));
            const float ang = (float)pos[t] * inv_freq;
            double rev = (double)ang * 0.15915494309189535; rev -= rint(rev);
            const float fr = (float)rev;
            CS[(size_t)t * 64 + d] = __builtin_amdgcn_cosf(fr); CS[(size_t)t * 64 + 32 + d] = __builtin_amdgcn_sinf(fr); }
        for (int i = gt; i < 8 * 128; i += NGT) { const int h = i >> 7, dist = i & 127; bias2[i] = rel_bias[t5_bucket(dist) * 8 + h] * LOG2E_F; }
    }
    GRID_BAR();

    }
#endif
#ifndef NO_P1
    {   GEO();
    {
        PTRS();
        pg8::Gemm g{P_H0, P_W_IN_T, MTOK, IN_N, DM}; pg8::StaticOrder S; S.init(MTOK, IN_N, G, bx);
        pg8::EpiInProj E{P_QA, P_KA, P_VA, P_CQ, P_CKV, P_KB, SSQ_Q, SSQ_KV, P_CS};
        pg8::gemm_phase<pg8::EpiInProj, pg8::StaticOrder, true, true>((LAS unsigned char*)lds, g, S, E, wave);
    }
    GRID_BAR();

    }
#endif
#ifndef NO_P2
    {   GEO();
#ifndef NO_QB
    {
        PTRS();
        pg8::Gemm g{P_CQ, P_W_QB_T, MTOK, QB_N, QL}; pg8::StaticOrder S; S.init(MTOK, QB_N, G, bx);
        pg8::EpiQB E{P_QB, SSQ_Q, P_CS};
        pg8::gemm_phase<pg8::EpiQB, pg8::StaticOrder, true, true>((LAS unsigned char*)lds, g, S, E, wave);
    }
#endif
#ifndef NO_KVB
    {
        PTRS();
        pg8::Gemm g{P_CKV, P_W_KVB_T, MTOK, KVB_N, KVL}; pg8::StaticOrder S; S.init(MTOK, KVB_N, G, bx);
        pg8::EpiKVB E{P_KB, P_VB, SSQ_KV};
        pg8::gemm_phase<pg8::EpiKVB, pg8::StaticOrder, true, true>((LAS unsigned char*)lds, g, S, E, wave);
    }
#endif
    GRID_BAR();

    }
#endif
#ifndef NO_P3
    {   GEO();
#ifndef NO_MLA
    {
        PTRS(); bf16* QBb = P_QB; bf16* KBb = P_KB; bf16* VBb = P_VB; bf16* MIX = P_MIX;
        using BB = att::Body<192, 128, 768, 768, 512, 1024, false, MLA_NQR>;
        static_assert(BB::LDS_BYTES <= MISC_OFF, "attention LDS");
        constexpr int NQB = SEQ / 256, NIT = BATCH * 4 * (NQB / 2);
        for (int L = vcu; L < NIT; L += G)
            for (int pass = 0; pass < 2; ++pass) {
                const int bh = L / (NQB / 2), xq = L % (NQB / 2), b = bh >> 2, h = bh & 3, qb = pass ? NQB - 1 - xq : xq;
                BB::Ref r; const size_t row0 = (size_t)b * SEQ;
                r.Q = QBb + (row0 + (size_t)qb * 256) * 768 + 192 * h; r.K = KBb + row0 * 768 + 192 * h; r.V = VBb + row0 * 512 + 128 * h;
                r.O = MIX + (row0 + (size_t)qb * 256) * 1024 + 512 + 128 * h; r.P0 = qb * 256; r.bias = nullptr; r.sink = 0.f;
                BB::block(r, SEQ, SEQ, (char*)lds, wave);
            }
    }
#endif
#if PROBE_MLA_REPS == 2
#ifndef NO_MLA
    {
        PTRS(); bf16* QBb = P_QB; bf16* KBb = P_KB; bf16* VBb = P_VB; bf16* MIX = P_MIX;
        using BB = att::Body<192, 128, 768, 768, 512, 1024, false, MLA_NQR>;
        static_assert(BB::LDS_BYTES <= MISC_OFF, "attention LDS");
        constexpr int NQB = SEQ / 256, NIT = BATCH * 4 * (NQB / 2);
        for (int L = vcu; L < NIT; L += G)
            for (int pass = 0; pass < 2; ++pass) {
                const int bh = L / (NQB / 2), xq = L % (NQB / 2), b = bh >> 2, h = bh & 3, qb = pass ? NQB - 1 - xq : xq;
                BB::Ref r; const size_t row0 = (size_t)b * SEQ;
                r.Q = QBb + (row0 + (size_t)qb * 256) * 768 + 192 * h; r.K = KBb + row0 * 768 + 192 * h; r.V = VBb + row0 * 512 + 128 * h;
                r.O = MIX + (row0 + (size_t)qb * 256) * 1024 + 512 + 128 * h; r.P0 = qb * 256; r.bias = nullptr; r.sink = 0.f;
                BB::block(r, SEQ, SEQ, (char*)lds, wave);
            }
    }
#endif
#endif
#ifndef NO_SWA
    {
        PTRS(); bf16* QA = P_QA; bf16* KA = P_KA; bf16* VA = P_VA; bf16* MIX = P_MIX; const float* bias2 = P_BIAS2; const float* sinks = A_->in[5];
        using BA = att::Body<64, 64, 512, 128, 128, 1024, true, 4>;
        constexpr int NQB = SEQ / 256, NIT = BATCH * 8 * NQB;
        for (int L = vcu; L < NIT; L += G) {
            const int bh = L / NQB, qb = L % NQB, b = bh >> 3, h = bh & 7;
            BA::Ref r; const size_t row0 = (size_t)b * SEQ;
            r.Q = QA + (row0 + (size_t)qb * 256) * 512 + 64 * h; r.K = KA + row0 * 128 + 64 * (h >> 2); r.V = VA + row0 * 128 + 64 * (h >> 2);
            r.O = MIX + (row0 + (size_t)qb * 256) * 1024 + 64 * h; r.P0 = qb * 256; r.bias = bias2 + 128 * h; r.sink = sinks[h] * LOG2E_F;
            BA::block(r, SEQ, 128, (char*)lds, wave);
        }
    }
#endif
#if PROBE_SWA_REPS == 2
#ifndef NO_SWA
    {
        PTRS(); bf16* QA = P_QA; bf16* KA = P_KA; bf16* VA = P_VA; bf16* MIX = P_MIX; const float* bias2 = P_BIAS2; const float* sinks = A_->in[5];
        using BA = att::Body<64, 64, 512, 128, 128, 1024, true, 4>;
        constexpr int NQB = SEQ / 256, NIT = BATCH * 8 * NQB;
        for (int L = vcu; L < NIT; L += G) {
            const int bh = L / NQB, qb = L % NQB, b = bh >> 3, h = bh & 7;
            BA::Ref r; const size_t row0 = (size_t)b * SEQ;
            r.Q = QA + (row0 + (size_t)qb * 256) * 512 + 64 * h; r.K = KA + row0 * 128 + 64 * (h >> 2); r.V = VA + row0 * 128 + 64 * (h >> 2);
            r.O = MIX + (row0 + (size_t)qb * 256) * 1024 + 64 * h; r.P0 = qb * 256; r.bias = bias2 + 128 * h; r.sink = sinks[h] * LOG2E_F;
            BA::block(r, SEQ, 128, (char*)lds, wave);
        }
    }
#endif
#endif
    GRID_BAR();

    }
#endif
#ifndef NO_P4
    {   GEO();
    { PTRS(); bf16* MIX = P_MIX; const float* a_out_g = A_->in[10]; const float* b_out_g = A_->in[11]; LANE_NOW(lane);
    for (int m = gw; m < MTOK; m += NGW) {
        GAS v4u* p = (GAS v4u*)(MIX + (size_t)m * 1024) + 2 * lane;
        const v4u a = p[0], b = p[1]; float f[16];
        const unsigned wv[8] = {a.x, a.y, a.z, a.w, b.x, b.y, b.z, b.w};
#pragma unroll
        for (int j = 0; j < 8; ++j) { f[2 * j] = __builtin_bit_cast(float, wv[j] << 16); f[2 * j + 1] = __builtin_bit_cast(float, wv[j] & 0xffff0000u); }
        float s = 0.f;
#pragma unroll
        for (int j = 0; j < 16; ++j) s += f[j] * f[j];
#pragma unroll
        for (int o = 1; o < 32; o <<= 1) s += __shfl_xor(s, o);
        const float rs = 1.f / sqrtf(s * (1.f / 512.f) + 1e-6f);
        const float* gp = (lane < 32 ? a_out_g : b_out_g) + 16 * (lane & 31);
        unsigned ow[8];
#pragma unroll
        for (int j = 0; j < 8; ++j) ow[j] = pk2(f[2 * j] * rs * gp[2 * j], f[2 * j + 1] * rs * gp[2 * j + 1]);
        p[0] = (v4u){ow[0], ow[1], ow[2], ow[3]}; p[1] = (v4u){ow[4], ow[5], ow[6], ow[7]};
    } }
    GRID_BAR();

    }
#endif
#ifndef NO_P5
    {   GEO();
    {
        PTRS();
        pg8::Gemm g{P_MIX, P_W_OUT_T, MTOK, DM, DM}; pg8::StaticOrder S; S.init(MTOK, DM, G, bx);
        pg8::EpiOut E{A_->in[0], A_->out, P_H0, SSQ2};
        pg8::gemm_phase<pg8::EpiOut, pg8::StaticOrder, true, true>((LAS unsigned char*)lds, g, S, E, wave);
    }
    GRID_BAR();

    }
#endif
#ifndef NO_P6
    {   GEO();
    {
        PTRS();
        pg8::Gemm g{P_H0, P_W_UP_T, MTOK, UP_N, DM}; pg8::StaticOrder S; S.init(MTOK, UP_N, G, bx);
        pg8::EpiUpConv E{P_ACT, P_EDGE, SSQ2, A_->in[15], A_->in[16]};
        pg8::gemm_phase<pg8::EpiUpConv, pg8::StaticOrder, UP_ALIGN, true>((LAS unsigned char*)lds, g, S, E, wave);
    }
    GRID_BAR();
    {
        PTRS(); const float* EDGE = P_EDGE; bf16* ACT = P_ACT; const float* conv_w = A_->in[15]; const float* conv_b = A_->in[16];
        LANE_NOW(lane); const int gt = gw * 64 + lane;
        for (int it = gt; it < (MTOK / 64) * DFF; it += NGT) {
            const int chunk = it / DFF, j = it - chunk * DFF, pn = j >> 7, col = j & 127;
            const float* e1 = EDGE + ((size_t)(chunk * 22 + pn) * 4) * 256 + col;
            float gm2 = 0.f, gm1 = 0.f, vm2 = 0.f, vm1 = 0.f;
            if ((chunk & (SEQ / 64 - 1)) != 0) { const float* e0 = e1 - (size_t)22 * 4 * 256; gm2 = e0[2 * 256]; gm1 = e0[3 * 256]; vm2 = e0[2 * 256 + 128]; vm1 = e0[3 * 256 + 128]; }
            const float g0 = e1[0], g1 = e1[256], v0 = e1[128], v1 = e1[256 + 128];
            const float wg0 = conv_w[j], wg1 = conv_w[UP_N + j], wg2 = conv_w[2 * UP_N + j], bg = conv_b[j];
            const float wv0 = conv_w[DFF + j], wv1 = conv_w[UP_N + DFF + j], wv2 = conv_w[2 * UP_N + DFF + j], bv = conv_b[DFF + j];
            const float ga = wg0 * gm2 + wg1 * gm1 + wg2 * g0 + bg, va = wv0 * vm2 + wv1 * vm1 + wv2 * v0 + bv;
            const float gb = wg0 * gm1 + wg1 * g0 + wg2 * g1 + bg, vb = wv0 * vm1 + wv1 * v0 + wv2 * v1 + bv;
            const float ra = ga * __builtin_amdgcn_rcpf(1.f + __builtin_amdgcn_exp2f(-ga * LOG2E_F)) * va;
            const float rb = gb * __builtin_amdgcn_rcpf(1.f + __builtin_amdgcn_exp2f(-gb * LOG2E_F)) * vb;
            ACT[(size_t)(chunk * 64) * DFF + j] = (bf16)f2bf(ra); ACT[(size_t)(chunk * 64 + 1) * DFF + j] = (bf16)f2bf(rb);
        }
    }
    GRID_BAR();
    }
#endif
#ifndef NO_P7
    {   GEO();
    {
        PTRS();
        pg8::Gemm g{P_ACT, P_W_DOWN_T, MTOK, DM, DFF}; pg8::StaticOrder S; S.init(MTOK, DM, G, bx);
        pg8::EpiDown E{A_->out, SSQ3};
        pg8::gemm_phase<pg8::EpiDown, pg8::StaticOrder, true, true>((LAS unsigned char*)lds, g, S, E, wave);
    }
    GRID_BAR();

    }
#endif
#ifndef NO_P8
    {   GEO();
    { PTRS(); float* out = A_->out; const float* final_g = A_->in[18]; const float* ssq3 = SSQ3; LANE_NOW(lane);
    for (int m = gw; m < MTOK; m += NGW) {
        GAS f32x4* xr = (GAS f32x4*)(out + (size_t)m * DM) + lane; const GAS f32x4* gr = (const GAS f32x4*)final_g + lane;
        const float rs = 1.f / sqrtf(ssq3[m] * (1.f / DM) + 1e-6f);
#pragma unroll
        for (int j = 0; j < 4; ++j) { const f32x4 v = xr[64 * j], gg = gr[64 * j]; xr[64 * j] = v * rs * gg; }
    } }
    }
#endif
}

extern "C" void kernel_launch(void* const* d_in, const int* in_sizes, int n_in, void* d_out, int out_size, void* d_ws, size_t ws_size, hipStream_t stream) {
    static int grid = 0;
    if (grid == 0) {
        if (n_in != 19 || in_sizes[0] != MTOK * DM || out_size != MTOK * DM || ws_size < WS_END) {
            fprintf(stderr, "kernel_launch: unexpected shapes (n_in %d, in0 %d, out %d, ws %zu)\n", n_in, n_in > 0 ? in_sizes[0] : -1, out_size, ws_size); grid = -1; return; }
        int dev = 0, cus = 0, per_cu = 0;
        (void)hipGetDevice(&dev); (void)hipDeviceGetAttribute(&cus, hipDeviceAttributeMultiprocessorCount, dev);
        if (hipFuncSetAttribute((const void*)hymba_fwd, hipFuncAttributeMaxDynamicSharedMemorySize, LDS_BYTES) != hipSuccess) { fprintf(stderr, "kernel_launch: hipFuncSetAttribute failed\n"); grid = -1; return; }
        if (hipOccupancyMaxActiveBlocksPerMultiprocessor(&per_cu, (const void*)hymba_fwd, NWAVES * 64, LDS_BYTES) != hipSuccess || per_cu < 1) { fprintf(stderr, "kernel_launch: occupancy query says %d\n", per_cu); per_cu = 1; }
        (void)hipGetLastError();
        grid = cus * 1;
        if (grid <= 0) grid = 256;
    }
    if (grid < 0) return;
    (void)hipMemsetAsync((char*)d_ws + WS_CTL, 0, CTL_ZERO_BYTES, stream);
    Args a{};
    for (int i = 0; i < 19; ++i) a.in[i] = (const float*)d_in[i];
    a.pos = (const int*)d_in[1]; a.out = (float*)d_out; a.ws = (unsigned char*)d_ws;
    void* kargs[] = {&a};
    hipError_t e = hipLaunchCooperativeKernel((const void*)hymba_fwd, dim3(grid), dim3(NWAVES * 64), kargs, LDS_BYTES, stream);
    if (e != hipSuccess) fprintf(stderr, "kernel_launch: cooperative launch failed: %s (grid %d)\n", hipGetErrorString(e), grid);
}
```

```cpp
#include <hip/hip_runtime.h>
#include <hip/hip_cooperative_groups.h>
#include <cstdio>
#include <cstdint>
namespace cg = cooperative_groups;

namespace pg8 {
#define PG8_LAS __attribute__((address_space(3)))
typedef unsigned short bf16_t;
typedef short bf16x8 __attribute__((ext_vector_type(8)));
typedef float f32x4 __attribute__((ext_vector_type(4)));
typedef unsigned u32x4 __attribute__((ext_vector_type(4)));
constexpr int BM = 256, BK = 64, HALF = 128, HTB = HALF * BK * 2  , STAGE_BYTES = 8 * HTB, NXCD = 8, WGM = 8;

__host__ __device__ __forceinline__ int lds_byte(int r, int c) { const int st = (r >> 4) * 2 + (c >> 5), rr = r & 15, cc = c & 31, ob = rr * 64 + cc * 2; return st * 1024 + (ob ^ (((ob >> 9) & 1) << 5)); }
__host__ __device__ __forceinline__ void stage_rc(int b, int& R, int& C) { const int st = b / 1024, sb = b % 1024, swz = sb ^ (((sb >> 9) & 1) << 5); R = (st >> 1) * 16 + swz / 64; C = (st & 1) * 32 + (swz % 64) / 2; }
__host__ __device__ __forceinline__ int perm32(int rho) { const int n = rho >> 4, i = rho & 15; return 8 * (i >> 2) + 4 * n + (i & 3); }

struct Unit { int pm, pn; };
struct Gemm { const bf16_t* A; const bf16_t* Bt; int M, N, K; };

struct StaticOrder {
    int nM, nN, nwg, G, c;
    __host__ __device__ void init(int M, int N, int G_, int c_) { nM = M / BM; nN = N / BM; nwg = nM * nN; G = G_; c = c_; }
    __host__ __device__ bool next(int i, Unit& u) const {
        const long L = (long)i * G + c; if (L >= nwg) return false;
        int wgid = (int)L; { const int q = nwg / NXCD, r = nwg % NXCD, xcd = wgid % NXCD, off = wgid / NXCD; wgid = (xcd < r ? xcd * (q + 1) : r * (q + 1) + (xcd - r) * q) + off; }
        const int nig = WGM * nN, gid = wgid / nig, fm = gid * WGM, gsz = (nM - fm) < WGM ? (nM - fm) : WGM;
        u.pm = fm + ((wgid % nig) % gsz); u.pn = (wgid % nig) / gsz; return true;
    }
    __device__ __forceinline__ void a_ready(const Unit&) const {}
    __device__ __forceinline__ void done(const Unit&) const {}
};


typedef unsigned u32x2 __attribute__((ext_vector_type(2)));
__device__ __forceinline__ unsigned cvt_pk_bf16(float lo, float hi) { unsigned r; asm volatile("v_cvt_pk_bf16_f32 %0, %1, %2" : "=v"(r) : "v"(lo), "v"(hi)); return r; }
__device__ __forceinline__ u32x4 pack8(f32x4 a, f32x4 b) { u32x4 w; w.x = cvt_pk_bf16(a[0], a[1]); w.y = cvt_pk_bf16(a[2], a[3]); w.z = cvt_pk_bf16(b[0], b[1]); w.w = cvt_pk_bf16(b[2], b[3]); return w; }
__device__ __forceinline__ u32x2 pack4(f32x4 a) { u32x2 w; w.x = cvt_pk_bf16(a[0], a[1]); w.y = cvt_pk_bf16(a[2], a[3]); return w; }
__device__ __forceinline__ float dot4(f32x4 a) { return (a[0] * a[0] + a[1] * a[1]) + (a[2] * a[2] + a[3] * a[3]); }
__device__ __forceinline__ float red_fq(float s) { s += __shfl_xor(s, 16); s += __shfl_xor(s, 32); return s; }

constexpr float RMS_EPS = 1e-6f;
constexpr float LOG2E = 1.4426950408889634f;
constexpr float C_A = 0.125f * LOG2E;
constexpr float C_B = 0.07216878364870322f * LOG2E;

struct EpiInProj {
    static constexpr bool PERM = true, AFTER_DRAIN = false;
    bf16_t *QA, *KA, *VA, *CQ, *CKV, *KB; float *ssq_q, *ssq_kv; const float* cs;
    __device__ __forceinline__ void operator()(const f32x4 (&acc)[2][2][4][2], const Unit& u, int wr, int wc, int fr, int fq) const {
        const int row0 = u.pm * BM + wr * 64 + fr, cw = wc * 32 + 8 * fq, pn = u.pn;
#pragma unroll
        for (int ai = 0; ai < 2; ++ai)
#pragma unroll
            for (int m = 0; m < 4; ++m) {
                const unsigned row = (unsigned)(row0 + ai * HALF + m * 16);
                if (pn < 2) {
#pragma unroll
                    for (int bj = 0; bj < 2; ++bj) *(u32x4*)(QA + row * 512 + pn * 256 + bj * HALF + cw) = pack8(acc[ai][bj][m][0] * C_A, acc[ai][bj][m][1] * C_A);
                } else if (pn == 2) {
                    *(u32x4*)(KA + row * 128 + cw) = pack8(acc[ai][0][m][0], acc[ai][0][m][1]);
                    *(u32x4*)(VA + row * 128 + cw) = pack8(acc[ai][1][m][0], acc[ai][1][m][1]);
                } else if (pn == 3) {
                    float s = 0.f;
#pragma unroll
                    for (int bj = 0; bj < 2; ++bj) { const f32x4 v0 = acc[ai][bj][m][0], v1 = acc[ai][bj][m][1]; s += dot4(v0) + dot4(v1);
                        *(u32x4*)(CQ + row * 256 + bj * HALF + cw) = pack8(v0, v1); }
                    s = red_fq(s); if (fq == 0) atomicAdd(ssq_q + row, s);
                } else {
                    { const f32x4 v0 = acc[ai][0][m][0], v1 = acc[ai][0][m][1]; float s = dot4(v0) + dot4(v1);
                      *(u32x4*)(CKV + row * 128 + cw) = pack8(v0, v1); s = red_fq(s); if (fq == 0) atomicAdd(ssq_kv + row, s); }
                    if (wc < 2) {
                        const int d = 4 * (4 * wc + fq); const f32x4 x1 = acc[ai][1][m][0], x2 = acc[ai][1][m][1];
                        const f32x4 c = *(const f32x4*)(cs + row * 64 + d), sn = *(const f32x4*)(cs + row * 64 + 32 + d);
                        const u32x2 y1 = pack4(x1 * c - x2 * sn), y2 = pack4(x1 * sn + x2 * c);
#pragma unroll
                        for (int h = 0; h < 4; ++h) { *(u32x2*)(KB + row * 768 + 192 * h + 128 + d) = y1; *(u32x2*)(KB + row * 768 + 192 * h + 160 + d) = y2; }
                    }
                }
                asm volatile("" ::: "memory");
            }
    }
};
struct EpiQB {
    static constexpr bool PERM = true, AFTER_DRAIN = false;
    bf16_t* QB; const float* ssq_q; const float* cs;
    __device__ __forceinline__ void operator()(const f32x4 (&acc)[2][2][4][2], const Unit& u, int wr, int wc, int fr, int fq) const {
        const int row0 = u.pm * BM + wr * 64 + fr, cw = wc * 32 + 8 * fq, pn = u.pn;
#pragma unroll
        for (int ai = 0; ai < 2; ++ai)
#pragma unroll
            for (int m = 0; m < 4; ++m) {
                const unsigned row = (unsigned)(row0 + ai * HALF + m * 16);
                const float rs = __builtin_amdgcn_rsqf(ssq_q[row] * (1.0f / 256.0f) + RMS_EPS) * C_B;
                if (pn < 2) {
#pragma unroll
                    for (int bj = 0; bj < 2; ++bj) *(u32x4*)(QB + row * 768 + 192 * (2 * pn + bj) + cw) = pack8(acc[ai][bj][m][0] * rs, acc[ai][bj][m][1] * rs);
                } else {
                    const int d = 4 * (4 * (wc & 1) + fq);
                    const f32x4 c = *(const f32x4*)(cs + row * 64 + d), sn = *(const f32x4*)(cs + row * 64 + 32 + d);
#pragma unroll
                    for (int bj = 0; bj < 2; ++bj) { const int h = 2 * bj + (wc >> 1); const f32x4 x1 = acc[ai][bj][m][0] * rs, x2 = acc[ai][bj][m][1] * rs;
                        *(u32x2*)(QB + row * 768 + 192 * h + 128 + d) = pack4(x1 * c - x2 * sn); *(u32x2*)(QB + row * 768 + 192 * h + 160 + d) = pack4(x1 * sn + x2 * c); }
                }
                asm volatile("" ::: "memory");
            }
    }
};
struct EpiKVB {
    static constexpr bool PERM = true, AFTER_DRAIN = false;
    bf16_t *KB, *VB; const float* ssq_kv;
    __device__ __forceinline__ void operator()(const f32x4 (&acc)[2][2][4][2], const Unit& u, int wr, int wc, int fr, int fq) const {
        const int row0 = u.pm * BM + wr * 64 + fr, cw = wc * 32 + 8 * fq, h = u.pn;
#pragma unroll
        for (int ai = 0; ai < 2; ++ai)
#pragma unroll
            for (int m = 0; m < 4; ++m) {
                const unsigned row = (unsigned)(row0 + ai * HALF + m * 16);
                const float rs = __builtin_amdgcn_rsqf(ssq_kv[row] * (1.0f / 128.0f) + RMS_EPS);
                *(u32x4*)(KB + row * 768 + 192 * h + cw) = pack8(acc[ai][0][m][0] * rs, acc[ai][0][m][1] * rs);
                *(u32x4*)(VB + row * 512 + 128 * h + cw) = pack8(acc[ai][1][m][0] * rs, acc[ai][1][m][1] * rs);
                asm volatile("" ::: "memory");
            }
    }
};
struct EpiOut {
    static constexpr bool PERM = false, AFTER_DRAIN = false;
    const float* x; float* X1; bf16_t* HB; float* ssq;
    __device__ __forceinline__ void operator()(const f32x4 (&acc)[2][2][4][2], const Unit& u, int wr, int wc, int fr, int fq) const {
        const int row0 = u.pm * BM + wr * 64 + fr, col0 = u.pn * BM + wc * 32 + 4 * fq;
#pragma unroll
        for (int ai = 0; ai < 2; ++ai)
#pragma unroll
            for (int m = 0; m < 4; ++m) {
                const unsigned row = (unsigned)(row0 + ai * HALF + m * 16); const unsigned off = row * 1024u + (unsigned)col0; float s = 0.f;
#pragma unroll
                for (int bj = 0; bj < 2; ++bj)
#pragma unroll
                    for (int n = 0; n < 2; ++n) { const unsigned o = off + (unsigned)(bj * HALF + n * 16); const f32x4 v = *(const f32x4*)(x + o) + acc[ai][bj][m][n];
                        *(f32x4*)(X1 + o) = v; *(u32x2*)(HB + o) = pack4(v); s += dot4(v); }
                s = red_fq(s); if (fq == 0) atomicAdd(ssq + row, s);
                asm volatile("" ::: "memory");
            }
    }
};
struct EpiUp {
    static constexpr bool PERM = true, AFTER_DRAIN = false;
    bf16_t* U; const float* ssq;
    __device__ __forceinline__ void operator()(const f32x4 (&acc)[2][2][4][2], const Unit& u, int wr, int wc, int fr, int fq) const {
        const int row0 = u.pm * BM + wr * 64 + fr, cw = u.pn * BM + wc * 32 + 8 * fq;
#pragma unroll
        for (int ai = 0; ai < 2; ++ai)
#pragma unroll
            for (int m = 0; m < 4; ++m) {
                const unsigned row = (unsigned)(row0 + ai * HALF + m * 16);
                const float rs = __builtin_amdgcn_rsqf(ssq[row] * (1.0f / 1024.0f) + RMS_EPS);
#pragma unroll
                for (int bj = 0; bj < 2; ++bj) *(u32x4*)(U + row * 5632 + bj * HALF + cw) = pack8(acc[ai][bj][m][0] * rs, acc[ai][bj][m][1] * rs);
                asm volatile("" ::: "memory");
            }
    }
};
template <int CTRL> __device__ __forceinline__ float dppmov(float old, float src) {
    return __builtin_bit_cast(float, __builtin_amdgcn_update_dpp(__builtin_bit_cast(int, old), __builtin_bit_cast(int, src), CTRL, 0xf, 0xf, false)); }
template <int CTRL> __device__ __forceinline__ f32x4 dppmov4(f32x4 old, f32x4 src) { f32x4 r; r[0] = dppmov<CTRL>(old[0], src[0]); r[1] = dppmov<CTRL>(old[1], src[1]); r[2] = dppmov<CTRL>(old[2], src[2]); r[3] = dppmov<CTRL>(old[3], src[3]); return r; }
struct EpiUpConv {
    static constexpr bool PERM = true, AFTER_DRAIN = false;
    bf16_t* ACT; float* EDGE; const float* ssq; const float* conv_w; const float* conv_b;
    __device__ __forceinline__ void operator()(const f32x4 (&acc)[2][2][4][2], const Unit& u, int wr, int wc, int fr, int fq) const {
        const int row0 = u.pm * BM + wr * 64 + fr, pn = u.pn;
        float rs[2][4];
#pragma unroll
        for (int ai = 0; ai < 2; ++ai)
#pragma unroll
            for (int m = 0; m < 4; ++m) rs[ai][m] = __builtin_amdgcn_rsqf(ssq[(unsigned)(row0 + ai * HALF + m * 16)] * (1.0f / 1024.0f) + RMS_EPS);
#pragma unroll
        for (int n = 0; n < 2; ++n) {
            const int ct = wc * 32 + 8 * fq + 4 * n;
            const unsigned ch = (unsigned)(pn * 128 + ct);
            const f32x4 wg0 = *(const f32x4*)(conv_w + ch), wg1 = *(const f32x4*)(conv_w + 5632u + ch), wg2 = *(const f32x4*)(conv_w + 11264u + ch), bg = *(const f32x4*)(conv_b + ch);
            const f32x4 wv0 = *(const f32x4*)(conv_w + 2816u + ch), wv1 = *(const f32x4*)(conv_w + 5632u + 2816u + ch), wv2 = *(const f32x4*)(conv_w + 11264u + 2816u + ch), bv = *(const f32x4*)(conv_b + 2816u + ch);
#pragma unroll
            for (int ai = 0; ai < 2; ++ai) {
                f32x4 pg = {0.f, 0.f, 0.f, 0.f}, pv = {0.f, 0.f, 0.f, 0.f};
                const unsigned chunk = (unsigned)(u.pm * 4 + ai * 2 + wr);
                float* eb = EDGE + ((size_t)(chunk * 22u + (unsigned)pn) * 4u) * 256u + ct;
#pragma unroll
                for (int m = 0; m < 4; ++m) {
                    const f32x4 cg = acc[ai][0][m][n] * rs[ai][m], cv = acc[ai][1][m][n] * rs[ai][m];
                    const f32x4 bg1 = dppmov4<0x121>(cg, pg), bg2 = dppmov4<0x122>(cg, pg), bv1 = dppmov4<0x121>(cv, pv), bv2 = dppmov4<0x122>(cv, pv);
                    const f32x4 g1 = dppmov4<0x111>(bg1, cg), g2 = dppmov4<0x112>(bg2, cg), v1 = dppmov4<0x111>(bv1, cv), v2 = dppmov4<0x112>(bv2, cv);
                    const f32x4 gs = wg0 * g2 + wg1 * g1 + wg2 * cg + bg, vs = wv0 * v2 + wv1 * v1 + wv2 * cv + bv;
                    f32x4 r;
#pragma unroll
                    for (int i = 0; i < 4; ++i) r[i] = gs[i] * __builtin_amdgcn_rcpf(1.f + __builtin_amdgcn_exp2f(-gs[i] * LOG2E)) * vs[i];
                    const unsigned row = (unsigned)(row0 + ai * HALF + m * 16);
                    if (m == 0) { if (fr >= 2) *(u32x2*)(ACT + row * 2816u + ch) = pack4(r);
                                  else { *(f32x4*)(eb + fr * 256) = cg; *(f32x4*)(eb + fr * 256 + 128) = cv; } }
                    else *(u32x2*)(ACT + row * 2816u + ch) = pack4(r);
                    if (m == 3) { if (fr >= 14) { *(f32x4*)(eb + (fr - 12) * 256) = cg; *(f32x4*)(eb + (fr - 12) * 256 + 128) = cv; } }
                    pg = cg; pv = cv;
                }
                asm volatile("" ::: "memory");
            }
        }
    }
};
struct EpiDown {
    static constexpr bool PERM = false, AFTER_DRAIN = false;
    float* X; float* ssq;
    __device__ __forceinline__ void operator()(const f32x4 (&acc)[2][2][4][2], const Unit& u, int wr, int wc, int fr, int fq) const {
        const int row0 = u.pm * BM + wr * 64 + fr, col0 = u.pn * BM + wc * 32 + 4 * fq;
#pragma unroll
        for (int ai = 0; ai < 2; ++ai)
#pragma unroll
            for (int m = 0; m < 4; ++m) {
                const unsigned row = (unsigned)(row0 + ai * HALF + m * 16); const unsigned off = row * 1024u + (unsigned)col0; float s = 0.f;
#pragma unroll
                for (int bj = 0; bj < 2; ++bj)
#pragma unroll
                    for (int n = 0; n < 2; ++n) { const unsigned o = off + (unsigned)(bj * HALF + n * 16); const f32x4 v = *(const f32x4*)(X + o) + acc[ai][bj][m][n];
                        *(f32x4*)(X + o) = v; s += dot4(v); }
                s = red_fq(s); if (fq == 0) atomicAdd(ssq + row, s);
                asm volatile("" ::: "memory");
            }
    }
};

template <class Epi, class Sched, bool ALIGN_EPI = false, bool SP2 = false>
__device__ __forceinline__ void gemm_phase(PG8_LAS unsigned char* lds, const Gemm g, const Sched& S, const Epi& E, const int wid) {
    int lane_v; asm volatile("v_mbcnt_lo_u32_b32 %0, -1, 0\n\tv_mbcnt_hi_u32_b32 %0, -1, %0" : "=v"(lane_v));
    const int lane = lane_v, tid = wid * 64 + lane, wr = wid >> 2, wc = wid & 3, fr = lane & 15, fq = lane >> 4;
    int K_o = g.K; asm volatile("" : "+s"(K_o));
    const int K = K_o, nt = K / BK;
    unsigned voffA[2], voffB[2];
#pragma unroll
    for (int i = 0; i < 2; ++i) { int R, C; stage_rc(tid * 16 + i * 8192, R, C); const int Rb = Epi::PERM ? ((R & ~31) + perm32(R & 31)) : R;
        voffA[i] = (unsigned)(R * K + C) * 2u; voffB[i] = (unsigned)(Rb * K + C) * 2u; }
    const size_t kstep = (size_t)(BK * 2);
    const size_t hstep = (size_t)HALF * K * 2;
    const size_t tstep = 2 * hstep;
    const unsigned ldsw = (unsigned)wid * 1024u;
    const int aoff = lds_byte(wr * 64 + fr, fq * 8), boff = lds_byte(wc * 32 + fr, fq * 8);
#define PG8_SA(b, h) (((b) * 2 + (h)) * HTB)
#define PG8_SB(b, h) ((4 + (b) * 2 + (h)) * HTB)
#define PG8_STAGE(bufoff, gbase, voff) do { _Pragma("unroll") for (int _i = 0; _i < 2; ++_i) \
        __builtin_amdgcn_global_load_lds((const unsigned*)((const char*)(gbase) + (voff)[_i]), (PG8_LAS unsigned*)(lds + (bufoff) + ldsw + _i * 8192), 16, 0, 0); } while (0)
#define PG8_LDA(dst, b, h) do { _Pragma("unroll") for (int m = 0; m < 4; ++m) _Pragma("unroll") for (int k = 0; k < 2; ++k) dst[m][k] = *(const PG8_LAS bf16x8*)(lds + PG8_SA(b, h) + aoff + m * 2048 + k * 1024); } while (0)
#define PG8_LDB(dst, b, h) do { _Pragma("unroll") for (int n = 0; n < 2; ++n) _Pragma("unroll") for (int k = 0; k < 2; ++k) dst[n][k] = *(const PG8_LAS bf16x8*)(lds + PG8_SB(b, h) + boff + n * 2048 + k * 1024); } while (0)
#define PG8_MMA(ai, bj, At, Bt) do { __builtin_amdgcn_s_setprio(1); _Pragma("unroll") for (int m = 0; m < 4; ++m) _Pragma("unroll") for (int n = 0; n < 2; ++n) _Pragma("unroll") for (int k = 0; k < 2; ++k) \
        acc[ai][bj][m][n] = __builtin_amdgcn_mfma_f32_16x16x32_bf16(Bt[n][k], At[m][k], acc[ai][bj][m][n], 0, 0, 0); __builtin_amdgcn_s_setprio(0); } while (0)
#define PG8_WAIT_V(n) asm volatile("s_waitcnt vmcnt(" #n ")" ::: "memory")
#define PG8_WAIT_L(n) asm volatile("s_waitcnt lgkmcnt(" #n ")" ::: "memory")
#define PG8_BAR __builtin_amdgcn_s_barrier()
#define PG8_SCHED __builtin_amdgcn_sched_barrier(0)
    Unit cur, nxt; int ui = 0;
    if (!S.next(0, cur)) return;
    f32x4 acc[2][2][4][2];
#pragma unroll
    for (int a = 0; a < 2; ++a)
#pragma unroll
        for (int b = 0; b < 2; ++b)
#pragma unroll
            for (int m = 0; m < 4; ++m)
#pragma unroll
                for (int n = 0; n < 2; ++n) acc[a][b][m][n] = (f32x4){0.f, 0.f, 0.f, 0.f};
    bf16x8 At[4][2], B0[2][2], B1[2][2];
    const char* cA = (const char*)g.A + (size_t)cur.pm * tstep; const char* cB = (const char*)g.Bt + (size_t)cur.pn * tstep;
    S.a_ready(cur);
    if constexpr (SP2) {
        PG8_STAGE(PG8_SB(0, 0), cB, voffB); PG8_STAGE(PG8_SB(0, 1), cB + hstep, voffB); PG8_STAGE(PG8_SA(0, 0), cA, voffA); PG8_STAGE(PG8_SA(0, 1), cA + hstep, voffA);
        if (wr == 1) PG8_BAR;
        PG8_WAIT_V(2); PG8_BAR;
        PG8_STAGE(PG8_SB(1, 0), cB + kstep, voffB); PG8_STAGE(PG8_SA(1, 0), cA + kstep, voffA); PG8_STAGE(PG8_SB(1, 1), cB + hstep + kstep, voffB);
        PG8_WAIT_V(6); PG8_BAR;
    } else {
        PG8_STAGE(PG8_SB(0, 0), cB, voffB); PG8_STAGE(PG8_SA(0, 0), cA, voffA); PG8_STAGE(PG8_SB(0, 1), cB + hstep, voffB); PG8_STAGE(PG8_SA(0, 1), cA + hstep, voffA);
        if (wr == 1) PG8_BAR;
        PG8_WAIT_V(4); PG8_BAR;
        PG8_STAGE(PG8_SB(1, 0), cB + kstep, voffB); PG8_STAGE(PG8_SA(1, 0), cA + kstep, voffA); PG8_STAGE(PG8_SB(1, 1), cB + hstep + kstep, voffB);
        PG8_WAIT_V(6); PG8_BAR;
    }
    for (;;) {
        const bool has_next = S.next(ui + 1, nxt);
        const char* nA = has_next ? (const char*)g.A + (size_t)nxt.pm * tstep : cA; const char* nB = has_next ? (const char*)g.Bt + (size_t)nxt.pn * tstep : cB;
        for (int t = 0; t < nt; t += 2) {
            const bool last = (t == nt - 2);
            const char* a1 = cA + (size_t)(t + 1) * kstep;
            const char* a2 = last ? nA : cA + (size_t)(t + 2) * kstep; const char* b2 = last ? nB : cB + (size_t)(t + 2) * kstep;
            const char* a3 = a2 + kstep; const char* b3 = b2 + kstep;
            if (last && has_next) S.a_ready(nxt);
            if constexpr (SP2) {
            PG8_LDB(B0, 0, 0); PG8_LDB(B1, 0, 1); PG8_SCHED; PG8_LDA(At, 0, 0); PG8_STAGE(PG8_SA(1, 1), a1 + hstep, voffA);
            PG8_WAIT_V(8); PG8_WAIT_L(0); PG8_BAR; PG8_MMA(0, 0, At, B0); PG8_MMA(0, 1, At, B1); PG8_BAR; PG8_SCHED;
            PG8_LDA(At, 0, 1); PG8_STAGE(PG8_SB(0, 0), b2, voffB); PG8_STAGE(PG8_SB(0, 1), b2 + hstep, voffB); PG8_STAGE(PG8_SA(0, 0), a2, voffA);
            PG8_WAIT_V(8); PG8_WAIT_L(0); PG8_BAR; PG8_MMA(1, 0, At, B0); PG8_MMA(1, 1, At, B1); PG8_BAR; PG8_SCHED;
            PG8_LDB(B0, 1, 0); PG8_LDB(B1, 1, 1); PG8_SCHED; PG8_LDA(At, 1, 0); PG8_STAGE(PG8_SA(0, 1), a2 + hstep, voffA);
            PG8_WAIT_V(8); PG8_WAIT_L(0); PG8_BAR; PG8_MMA(0, 0, At, B0); PG8_MMA(0, 1, At, B1); PG8_BAR; PG8_SCHED;
            PG8_LDA(At, 1, 1); PG8_STAGE(PG8_SB(1, 0), b3, voffB); PG8_STAGE(PG8_SB(1, 1), b3 + hstep, voffB); PG8_STAGE(PG8_SA(1, 0), a3, voffA);
            PG8_WAIT_V(8); PG8_WAIT_L(0); PG8_BAR; PG8_MMA(1, 0, At, B0); PG8_MMA(1, 1, At, B1); PG8_BAR; PG8_SCHED;
            } else {
            PG8_LDB(B0, 0, 0); PG8_SCHED; PG8_LDA(At, 0, 0); PG8_STAGE(PG8_SA(1, 1), a1 + hstep, voffA);
            PG8_WAIT_L(8); PG8_BAR; PG8_WAIT_L(0); PG8_MMA(0, 0, At, B0); PG8_BAR; PG8_SCHED;
            PG8_LDB(B1, 0, 1); PG8_STAGE(PG8_SB(0, 0), b2, voffB);
            PG8_BAR; PG8_WAIT_L(0); PG8_MMA(0, 1, At, B1); PG8_BAR;
            PG8_LDA(At, 0, 1); PG8_STAGE(PG8_SA(0, 0), a2, voffA);
            PG8_BAR; PG8_WAIT_L(0); PG8_MMA(1, 0, At, B0); PG8_BAR; PG8_SCHED;
            PG8_STAGE(PG8_SB(0, 1), b2 + hstep, voffB);
            PG8_WAIT_V(6); PG8_BAR; PG8_MMA(1, 1, At, B1); PG8_BAR;
            PG8_LDB(B0, 1, 0); PG8_SCHED; PG8_LDA(At, 1, 0); PG8_STAGE(PG8_SA(0, 1), a2 + hstep, voffA);
            PG8_WAIT_L(8); PG8_BAR; PG8_WAIT_L(0); PG8_MMA(0, 0, At, B0); PG8_BAR; PG8_SCHED;
            PG8_LDB(B1, 1, 1); PG8_STAGE(PG8_SB(1, 0), b3, voffB);
            PG8_BAR; PG8_WAIT_L(0); PG8_MMA(0, 1, At, B1); PG8_BAR;
            PG8_LDA(At, 1, 1); PG8_STAGE(PG8_SA(1, 0), a3, voffA);
            PG8_BAR; PG8_WAIT_L(0); PG8_MMA(1, 0, At, B0); PG8_BAR; PG8_SCHED;
            PG8_STAGE(PG8_SB(1, 1), b3 + hstep, voffB);
            PG8_WAIT_V(6); PG8_BAR; PG8_MMA(1, 1, At, B1); PG8_BAR;
            }
        }
        if constexpr (ALIGN_EPI) { if (wr == 0) PG8_BAR; }
        if constexpr (!Epi::AFTER_DRAIN) { E(acc, cur, wr, wc, fr, fq); S.done(cur); }
        if (!has_next) break;
#pragma unroll
        for (int a = 0; a < 2; ++a)
#pragma unroll
            for (int b = 0; b < 2; ++b)
#pragma unroll
                for (int m = 0; m < 4; ++m)
#pragma unroll
                    for (int n = 0; n < 2; ++n) acc[a][b][m][n] = (f32x4){0.f, 0.f, 0.f, 0.f};
        cur = nxt; cA = nA; cB = nB; ++ui;
        if constexpr (ALIGN_EPI) { if (wr == 1) PG8_BAR; }
    }
    PG8_WAIT_V(0);
    if constexpr (!ALIGN_EPI) { if (wr == 0) PG8_BAR; }
    PG8_BAR;
    if constexpr (Epi::AFTER_DRAIN) { E.fused(acc, cur, wr, wc, fr, fq, lds, wid, lane); S.done(cur); }
#undef PG8_SA
#undef PG8_SB
#undef PG8_STAGE
#undef PG8_LDA
#undef PG8_LDB
#undef PG8_MMA
#undef PG8_WAIT_V
#undef PG8_WAIT_L
#undef PG8_BAR
#undef PG8_SCHED
}
}

namespace att {
typedef unsigned short bf16_t;
typedef short bf16x8 __attribute__((ext_vector_type(8)));
typedef short s16x4 __attribute__((ext_vector_type(4)));
typedef float f32x16 __attribute__((ext_vector_type(16)));
typedef float f32x4 __attribute__((ext_vector_type(4)));
typedef unsigned u32x4 __attribute__((ext_vector_type(4)));
constexpr int NW = 8, QBLK = 32, KVBLK = 64, QB = NW * QBLK;
constexpr float THRL = 8.f;
#define SBAR() __builtin_amdgcn_sched_barrier(0)
__device__ __forceinline__ int crow(int r, int hi) { return (r & 3) + 8 * (r >> 2) + 4 * hi; }
__device__ __forceinline__ unsigned cvtpk(float lo, float hi) { unsigned r; asm volatile("v_cvt_pk_bf16_f32 %0, %1, %2" : "=v"(r) : "v"(lo), "v"(hi)); return r; }
__device__ __forceinline__ int v_rd_base(int lane) { return ((lane & 3) << 3) | (((lane >> 2) & 3) << 6) | (((lane >> 4) & 1) << 5) | (((lane >> 5) & 1) << 8); }
__device__ __forceinline__ void mask_tile(f32x16& p0, f32x16& p1, int dq, unsigned W) {
    const float NEG = -__builtin_inff();
#pragma unroll
    for (int r = 0; r < 16; ++r) { const int c = (r & 3) + 8 * (r >> 2);
        if ((unsigned)(dq - c) >= W) p0[r] = NEG;
        if ((unsigned)(dq - c - 32) >= W) p1[r] = NEG; }
}
__device__ __forceinline__ void bias_tile(f32x16& p0, f32x16& p1, int dq, const float* tb) {
#pragma unroll
    for (int r = 0; r < 16; ++r) { const int c = (r & 3) + 8 * (r >> 2);
        p0[r] += tb[(dq - c) & 255];
        p1[r] += tb[(dq - c - 32) & 255]; }
}
__device__ __forceinline__ void partialSM(f32x16& p0, f32x16& p1, float& m_reg, float& mn, float& alpha) {
    float pmax = p0[0];
#pragma unroll
    for (int r = 1; r < 16; ++r) pmax = fmaxf(pmax, p0[r]);
#pragma unroll
    for (int r = 0; r < 16; ++r) pmax = fmaxf(pmax, p1[r]);
    { auto rr = __builtin_amdgcn_permlane32_swap(__float_as_uint(pmax), __float_as_uint(pmax), false, false);
      pmax = fmaxf(__uint_as_float(rr[0]), __uint_as_float(rr[1])); }
    if (__builtin_expect(__all((pmax - m_reg) <= THRL), 1)) { mn = m_reg; alpha = 1.f; }
    else { mn = fmaxf(m_reg, pmax); alpha = __builtin_amdgcn_exp2f(m_reg - mn); m_reg = mn; }
#pragma unroll
    for (int r = 0; r < 16; ++r) p0[r] -= mn;
#pragma unroll
    for (int r = 0; r < 16; ++r) p1[r] -= mn;
#pragma unroll
    for (int r = 0; r < 16; ++r) p0[r] = __builtin_amdgcn_exp2f(p0[r]);
}
__device__ __forceinline__ void finishSM(f32x16& p0, f32x16& p1, float alpha, float& l_reg, bf16x8& pa0, bf16x8& pa1, bf16x8& pa2, bf16x8& pa3) {
#pragma unroll
    for (int r = 0; r < 16; ++r) p1[r] = __builtin_amdgcn_exp2f(p1[r]);
    float ps = 0;
#pragma unroll
    for (int r = 0; r < 16; ++r) ps += p0[r];
#pragma unroll
    for (int r = 0; r < 16; ++r) ps += p1[r];
    { auto rr = __builtin_amdgcn_permlane32_swap(__float_as_uint(ps), __float_as_uint(ps), false, false);
      ps = __uint_as_float(rr[0]) + __uint_as_float(rr[1]); }
    l_reg = l_reg * alpha + ps;
#define PK4(P, B_, OUT) do { unsigned a0 = cvtpk(P[B_+0], P[B_+1]), a1 = cvtpk(P[B_+2], P[B_+3]);                          \
        unsigned b0 = cvtpk(P[B_+4], P[B_+5]), b1 = cvtpk(P[B_+6], P[B_+7]);                                             \
        auto r0 = __builtin_amdgcn_permlane32_swap(a0, b0, false, false); auto r1 = __builtin_amdgcn_permlane32_swap(a1, b1, false, false); \
        u32x4 w = {r0[0], r1[0], r0[1], r1[1]}; OUT = *reinterpret_cast<bf16x8*>(&w); } while (0)
    PK4(p0, 0, pa0); PK4(p0, 8, pa1); PK4(p1, 0, pa2); PK4(p1, 8, pa3);
#undef PK4
}

template <int DQK, int DV, int LDQ, int LDK, int LDV, int LDO, bool SWA, int NQR>
struct Body {
    static constexpr int KROW = DQK * 2, SHM_K = KVBLK * KROW, SHM_V = KVBLK * DV * 2, NCB = DV / 32, KS_STR = 2 * NCB * 512, HF_STR = NCB * 512;
    static constexpr int ND = DQK / 16, NKP = (DQK == 192) ? 3 : 1, NVP = DV / 64, NDV = DV / 32;
    static constexpr int OFF_V = 0, OFF_K = 2 * SHM_V, OFF_WS = OFF_K + 2 * SHM_K, OFF_TBL = OFF_WS + NW * 64 * 4, OFF_QL = OFF_TBL + 2048, NQL_LDS = DQK / 16 - NQR, QL_WAVE = QBLK * NQL_LDS * 32, LDS_BYTES = OFF_QL + NW * QL_WAVE;
    static constexpr bool SK = SWA;
    static_assert((DQK == 192 || DQK == 64) && (DV == 128 || DV == 64), "geometry");
    struct Ref { const bf16_t* Q; const bf16_t* K; const bf16_t* V; bf16_t* O; int P0; const float* bias; float sink; };
    struct Seam { bf16x8 qr[NQR]; bf16x8 st_k[NKP]; bf16x8 st_v[NVP]; };

    static __device__ __forceinline__ int kswz(int row, int colB) { return row * KROW + (colB ^ (((row >> 1) & 7) << 4)); }
    static __device__ __forceinline__ int v_st(int k, int c) { const int kk = (k & ~0xC) | ((k & 4) << 1) | ((k & 8) >> 1); return ((kk >> 3) * NCB + (c >> 5)) * 512 + ((kk & 7) * 32 + (c & 31)) * 2; }
    static __device__ __forceinline__ void kpiece(int tid, int p, int& row, int& col) {
        if (DQK == 192) { if (p < 2) { row = (tid >> 4) + 32 * p; col = (tid & 15) * 8; } else { row = tid >> 3; col = 128 + (tid & 7) * 8; } }
        else { row = tid >> 3; col = (tid & 7) * 8; }
    }
    static __device__ __forceinline__ void vpiece(int tid, int p, int& row, int& col) {
        if (DV == 128) { row = (tid >> 4) + 32 * p; col = (tid & 15) * 8; } else { row = tid >> 3; col = (tid & 7) * 8; }
    }
    static __device__ __forceinline__ int swa_jlo(int P0, int W) { const int lowk = P0 - W + 1; return lowk > 0 ? lowk / KVBLK : 0; }

#define QSWZ(r_) ((NQL_LDS * 32) % 256 == 0 ? ((r_) & 15) : (((r_) >> 1) & 7))
    template <int KB>
    static __device__ __forceinline__ void qkt(f32x16& p0, f32x16& p1, const char* K_lds, int r32, int hi, const bf16x8* qr, const char* qlw, bool act) {
        if (SK && !act) { const float NEG = -__builtin_inff();
#pragma unroll
            for (int r = 0; r < 16; ++r) { p0[r] = NEG; p1[r] = NEG; } return; }
        p0 = f32x16{}; p1 = f32x16{};
        const char* kb[4];
#pragma unroll
        for (int dd = 0; dd < 4; ++dd) kb[dd] = K_lds + KB * SHM_K + kswz(r32, (dd * 16 + hi * 8) * 2);
        constexpr int PD = (ND < 4) ? ND : 4;
        bf16x8 rk0[PD], rk1[PD], rq[PD];
#define QK_LOAD(d0_, s_) do { const char* a_ = kb[(d0_) & 3] + ((d0_) >> 2) * 128; \
            rk0[s_] = *reinterpret_cast<const bf16x8*>(a_); rk1[s_] = *reinterpret_cast<const bf16x8*>(a_ + 32 * KROW); \
            if ((d0_) >= NQR) rq[s_] = *reinterpret_cast<const bf16x8*>(qlw + (((2 * ((d0_) - NQR) + hi) * 16) ^ (QSWZ(r32) << 4))); } while (0)
#pragma unroll
        for (int d0 = 0; d0 < PD; ++d0) QK_LOAD(d0, d0);
#pragma unroll
        for (int d0 = 0; d0 < ND; ++d0) {
            SBAR();
            const bf16x8 qf = (d0 < NQR) ? qr[d0 < NQR ? d0 : 0] : rq[d0 % PD];
            p0 = __builtin_amdgcn_mfma_f32_32x32x16_bf16(rk0[d0 % PD], qf, p0, 0, 0, 0);
            p1 = __builtin_amdgcn_mfma_f32_32x32x16_bf16(rk1[d0 % PD], qf, p1, 0, 0, 0);
            SBAR();
            if (d0 + PD < ND) QK_LOAD(d0 + PD, d0 % PD);
        }
#undef QK_LOAD
    }
    template <int VB>
    static __device__ __forceinline__ void pv_tile(f32x16* o, int vb0, bf16x8 pa0, bf16x8 pa1, bf16x8 pa2, bf16x8 pa3, bool act) {
        if (SK && !act) return;
#define TRRD(dst, off) asm volatile("ds_read_b64_tr_b16 %0, %1 offset:%2" : "=&v"(dst) : "v"(vb0), "i"(off) : "memory")
#define PV_RD(d0, L, H) do { constexpr int b_ = VB * SHM_V + (d0) * 512; \
        TRRD(L[0], b_); TRRD(H[0], b_ + HF_STR); TRRD(L[1], b_ + KS_STR); TRRD(H[1], b_ + KS_STR + HF_STR); TRRD(L[2], b_ + 2 * KS_STR); TRRD(H[2], b_ + 2 * KS_STR + HF_STR); TRRD(L[3], b_ + 3 * KS_STR); TRRD(H[3], b_ + 3 * KS_STR + HF_STR); } while (0)
#define PV_MM(d0, L, H) do { \
        o[d0] = __builtin_amdgcn_mfma_f32_32x32x16_bf16(pa0, (bf16x8){L[0][0], L[0][1], L[0][2], L[0][3], H[0][0], H[0][1], H[0][2], H[0][3]}, o[d0], 0, 0, 0);   \
        o[d0] = __builtin_amdgcn_mfma_f32_32x32x16_bf16(pa1, (bf16x8){L[1][0], L[1][1], L[1][2], L[1][3], H[1][0], H[1][1], H[1][2], H[1][3]}, o[d0], 0, 0, 0);   \
        o[d0] = __builtin_amdgcn_mfma_f32_32x32x16_bf16(pa2, (bf16x8){L[2][0], L[2][1], L[2][2], L[2][3], H[2][0], H[2][1], H[2][2], H[2][3]}, o[d0], 0, 0, 0);   \
        o[d0] = __builtin_amdgcn_mfma_f32_32x32x16_bf16(pa3, (bf16x8){L[3][0], L[3][1], L[3][2], L[3][3], H[3][0], H[3][1], H[3][2], H[3][3]}, o[d0], 0, 0, 0); } while (0)
#define LGK_WAIT(n) do { asm volatile("s_waitcnt lgkmcnt(%0)" :: "i"(n) : "memory"); SBAR(); } while (0)
        s16x4 la[4], ha[4], lb[4], hb[4];
        SBAR();
        PV_RD(0, la, ha); PV_RD(1, lb, hb); LGK_WAIT(8); PV_MM(0, la, ha); SBAR();
        if constexpr (NDV == 4) {
            PV_RD(2, la, ha); LGK_WAIT(8); PV_MM(1, lb, hb); SBAR();
            PV_RD(3, lb, hb); LGK_WAIT(8); PV_MM(2, la, ha); SBAR();
            LGK_WAIT(0); PV_MM(3, lb, hb);
        } else {
            LGK_WAIT(0); PV_MM(1, lb, hb);
        }
        SBAR();
#undef LGK_WAIT
#undef PV_MM
#undef PV_RD
#undef TRRD
    }

#define VMW() asm volatile("s_waitcnt vmcnt(0)" ::: "memory")
#define VMWN(n) asm volatile("s_waitcnt vmcnt(%0)" :: "i"(n) : "memory")
#define SLOAD_H(Kp, Vp, k0) do { \
        _Pragma("unroll") for (int p_ = 0; p_ < NVP; ++p_) { int rr_, cc_; vpiece(tid, p_, rr_, cc_); S.st_v[p_] = *reinterpret_cast<const bf16x8*>((Vp) + (unsigned)(((k0) + rr_) * LDV + cc_)); } \
        _Pragma("unroll") for (int p_ = 0; p_ < NKP; ++p_) { int rr_, cc_; kpiece(tid, p_, rr_, cc_); S.st_k[p_] = *reinterpret_cast<const bf16x8*>((Kp) + (unsigned)(((k0) + rr_) * LDK + cc_)); } } while (0)
#define SWRITE_HK(bf) do { _Pragma("unroll") for (int p_ = 0; p_ < NKP; ++p_) { int rr_, cc_; kpiece(tid, p_, rr_, cc_); *(bf16x8*)(K_lds + (bf) * SHM_K + kswz(rr_, cc_ * 2)) = S.st_k[p_]; } } while (0)
#define SWRITE_HV(bf) do { _Pragma("unroll") for (int p_ = 0; p_ < NVP; ++p_) { int rr_, cc_; vpiece(tid, p_, rr_, cc_); *(bf16x8*)(V_lds + (bf) * SHM_V + v_st(rr_, cc_)) = S.st_v[p_]; } } while (0)
#define SWRITE_H(bf) do { SWRITE_HV(bf); SWRITE_HK(bf); } while (0)
#define QLOAD(ref) do { _Pragma("unroll") for (int d0 = 0; d0 < NQR; ++d0) S.qr[d0] = *reinterpret_cast<const bf16x8*>((ref).Q + (size_t)(wid * QBLK + r32) * LDQ + d0 * 16 + hi * 8); } while (0)
#define QLDS_FILL(ref) do { if constexpr (NQL_LDS > 0) { bf16x8 t_[NQL_LDS]; \
        _Pragma("unroll") for (int e_ = 0; e_ < NQL_LDS; ++e_) t_[e_] = *reinterpret_cast<const bf16x8*>((ref).Q + (size_t)(wid * QBLK + r32) * LDQ + (NQR + e_) * 16 + hi * 8); \
        _Pragma("unroll") for (int e_ = 0; e_ < NQL_LDS; ++e_) *(bf16x8*)(lds + OFF_QL + wid * QL_WAVE + r32 * (NQL_LDS * 32) + (((2 * e_ + hi) * 16) ^ (QSWZ(r32) << 4))) = t_[e_]; \
        asm volatile("s_waitcnt lgkmcnt(0)" ::: "memory"); } } while (0)

    static __device__ __forceinline__ void block(const Ref& cur, int skv, int W, char* lds, const int wid) {
        int lane_v; asm volatile("v_mbcnt_lo_u32_b32 %0, -1, 0\n\tv_mbcnt_hi_u32_b32 %0, -1, %0" : "=v"(lane_v));
        const int lane = lane_v, tid = wid * 64 + lane, r32 = lane & 31, hi = lane >> 5;
        Seam S;
        const int j_lo = swa_jlo(cur.P0, W);
        int j_hi = (cur.P0 + QB - 1) / KVBLK + 1; if (j_hi > skv / KVBLK) j_hi = skv / KVBLK;
        const int NT = j_hi - j_lo;
        const int qlo = cur.P0 + wid * QBLK, qm = qlo + r32 - 4 * hi;
        char* V_lds = lds + OFF_V; char* K_lds = lds + OFF_K;
        float* ws = (float*)(lds + OFF_WS) + wid * 64; float* li_l = ws, * al_l = ws + 32;
        const float* tb = (const float*)(lds + OFF_TBL);
        const char* qlw = lds + OFF_QL + wid * QL_WAVE + r32 * (NQL_LDS * 32);
        float m_reg = SWA ? cur.sink : -1e30f, l_reg = SWA ? 1.f : 0.f; f32x16 o[NDV];
#pragma unroll
        for (int d_ = 0; d_ < NDV; ++d_) o[d_] = f32x16{};
        const int vb0 = (int)(uintptr_t)V_lds + v_rd_base(lane);
        const bf16_t* Kh = cur.K; const bf16_t* Vh = cur.V;
#define KBASE(t) ((j_lo + (t)) * KVBLK)
#define ACT(t) (KBASE(t) <= qlo + QBLK - 1 && KBASE(t) + KVBLK - 1 >= qlo - W + 1)
        QLOAD(cur); QLDS_FILL(cur);
        if (SWA) { if (tid < 256) ((float*)(lds + OFF_TBL))[tid] = tid < 128 ? cur.bias[tid] : 0.f; }
        SLOAD_H(Kh, Vh, KBASE(0)); VMW(); SWRITE_H(0);
        const int grp = wid >> 2;
        if (grp == 1 && NT > 1) { SLOAD_H(Kh, Vh, KBASE(1)); }
        __syncthreads();
        if (grp == 1) __syncthreads();
        for (int t = 0; t < NT; ++t) {
            const int bo = t & 1;
            f32x16 p0, p1; float mn, alpha; bf16x8 pa0, pa1, pa2, pa3;
            const bool act = ACT(t);
            if (grp == 0 && t + 1 < NT) { SLOAD_H(Kh, Vh, KBASE(t + 1)); }
            SBAR();
            if (bo == 0) qkt<0>(p0, p1, K_lds, r32, hi, S.qr, qlw, act); else qkt<1>(p0, p1, K_lds, r32, hi, S.qr, qlw, act);
            SBAR();
            { const int kb_ = KBASE(t);
              if (!SK || act) { if (SWA) bias_tile(p0, p1, qm - kb_, tb);
                  if (kb_ + KVBLK - 1 > qlo || kb_ <= qlo + QBLK - 1 - W) mask_tile(p0, p1, qm - kb_, (unsigned)W); } }
            partialSM(p0, p1, m_reg, mn, alpha);
            SBAR();
            if (grp == 1 && t + 1 < NT) { VMW(); if (bo == 0) { SWRITE_H(1); } else { SWRITE_H(0); } }
            __syncthreads();
            if (grp == 1 && t + 2 < NT) { SLOAD_H(Kh, Vh, KBASE(t + 2)); }
            SBAR();
            if (__any(alpha < 1.f)) { if (hi == 0) al_l[r32] = alpha; asm volatile("s_waitcnt lgkmcnt(0)" ::: "memory");
#pragma unroll
                for (int d_ = 0; d_ < NDV; ++d_)
#pragma unroll
                    for (int r = 0; r < 16; ++r) o[d_][r] *= al_l[crow(r, hi)]; }
            finishSM(p0, p1, alpha, l_reg, pa0, pa1, pa2, pa3); SBAR();
            if (bo == 0) pv_tile<0>(o, vb0, pa0, pa1, pa2, pa3, act); else pv_tile<1>(o, vb0, pa0, pa1, pa2, pa3, act);
            SBAR();
#if defined(PROBE_XMFMA)
            if (!SWA) { bf16x8 z_ = {0, 0, 0, 0, 0, 0, 0, 0}; asm volatile("" : "+v"(z_));
#pragma unroll
                for (int x_ = 0; x_ < PROBE_XMFMA; ++x_) o[x_ & 3] = __builtin_amdgcn_mfma_f32_32x32x16_bf16(z_, pa0, o[x_ & 3], 0, 0, 0);
                SBAR(); }
#endif
#if defined(PROBE_XVALU)
            if (!SWA) { float dz_ = 0.f; asm volatile("" : "+v"(dz_));
#pragma unroll
                for (int x_ = 0; x_ < PROBE_XVALU; ++x_) asm volatile("v_add_f32 %0, %0, %0" : "+v"(dz_));
                SBAR(); }
#endif
            if (grp == 0 && t + 1 < NT) { VMW(); if (bo == 0) { SWRITE_H(1); } else { SWRITE_H(0); } }
            __syncthreads();
        }
        if (grp == 0) __syncthreads();
        if (hi == 0) li_l[r32] = l_reg; asm volatile("s_waitcnt lgkmcnt(0)" ::: "memory");
        float rli[16];
#pragma unroll
        for (int r = 0; r < 16; ++r) rli[r] = __builtin_amdgcn_rcpf(li_l[crow(r, hi)]);
        bf16_t* Ow = cur.O + (size_t)(wid * QBLK) * LDO;
#pragma unroll
        for (int r = 0; r < 16; ++r) { const int orow = crow(r, hi);
#pragma unroll
            for (int d0 = 0; d0 < NDV; ++d0) { const float v = o[d0][r] * rli[r];
                const float vn = __shfl_xor(v, 1);
                if ((r32 & 1) == 0) *(unsigned*)(Ow + (size_t)orow * LDO + d0 * 32 + r32) = cvtpk(v, vn); } }
        __syncthreads();
#undef KBASE
#undef ACT
    }
#undef VMW
#undef VMWN
#undef SLOAD_H
#undef SWRITE_HK
#undef SWRITE_HV
#undef SWRITE_H
#undef QLOAD
#undef QLDS_FILL
#undef QSWZ
};
#undef SBAR
}

constexpr int NWAVES = 8;
constexpr int BATCH = 2, SEQ = 16384, DM = 1024, MTOK = BATCH * SEQ;
constexpr int IN_COLS = 1216, IN_N = 1280, QB_N = 768, KVB_N = 1024, QL = 256, KVL = 128, DFF = 2816, UP_N = 5632;
constexpr float LOG2E_F = 1.4426950408889634f;
#ifndef PROBE_MLA_REPS
#define PROBE_MLA_REPS 1
#endif
#ifndef PROBE_SWA_REPS
#define PROBE_SWA_REPS 1
#endif
#ifndef UP_ALIGN
#define UP_ALIGN true
#endif
#ifndef MLA_NQR
#define MLA_NQR 4
#endif

constexpr size_t MiB = 1u << 20;
constexpr size_t WS_CTL = 0, CTL_ZERO_BYTES = 1 * MiB;
constexpr size_t WS_BIAS = 1 * MiB;
constexpr size_t WS_WIN = 2 * MiB, WS_WQB = 5 * MiB, WS_WKVB = 6 * MiB, WS_WOUT = 7 * MiB, WS_WUP = 9 * MiB, WS_WDOWN = 20 * MiB;
constexpr size_t WS_CS = 26 * MiB;
constexpr size_t WS_H0 = 34 * MiB;
constexpr size_t WS_QA = 98 * MiB, WS_KA = 130 * MiB, WS_VA = 138 * MiB, WS_CQ = 146 * MiB, WS_CKV = 162 * MiB, WS_QB = 170 * MiB, WS_KB = 218 * MiB, WS_VB = 266 * MiB, WS_MIX = 298 * MiB;
constexpr size_t WS_ACT = 98 * MiB;
constexpr size_t WS_U = 274 * MiB;
constexpr size_t WS_EDGE = 274 * MiB;
constexpr size_t WS_END = 450 * MiB;

constexpr int RING_BYTES = 131072, LDS_BYTES = 163840;

#define GAS __attribute__((address_space(1)))
#define LAS __attribute__((address_space(3)))
typedef unsigned short bf16;
typedef unsigned v4u __attribute__((ext_vector_type(4)));
typedef unsigned v2u __attribute__((ext_vector_type(2)));
typedef float f32x4 __attribute__((ext_vector_type(4)));
#define LDS_WAIT() asm volatile("s_waitcnt lgkmcnt(0)" ::: "memory")
__device__ __forceinline__ unsigned f2bf(float f) { unsigned u = __builtin_bit_cast(unsigned, f); return (u + 0x7fffu + ((u >> 16) & 1u)) >> 16; }
__device__ __forceinline__ unsigned pk2(float lo, float hi) { return f2bf(lo) | (f2bf(hi) << 16); }
__device__ __forceinline__ float bf2f(unsigned short b) { return __builtin_bit_cast(float, (unsigned)b << 16); }
__device__ __forceinline__ float wave_sum(float v) {
#pragma unroll
    for (int o = 1; o < 64; o <<= 1) v += __shfl_xor(v, o);
    return v;
}

typedef GAS unsigned gu32;
#define RLX_AGENT __ATOMIC_RELAXED, __HIP_MEMORY_SCOPE_AGENT
constexpr size_t WS_BAR = 768 * 1024;
constexpr int MISC_OFF = 163840 - 64;
#define XB_TMO      128
#define XB_XCNT(j)  (256  + 64 * (j))
#define XB_XSUB(j)  (1280 + 64 * (j))
#define XB_XGEN(j)  (2304 + 64 * (j))
#define XB_TOP      3328
#define XB_TOPGEN   3392
#define XCD_BAR_WORDS 3456
#define XB_SPIN_CAP (1u << 18)

__device__ __forceinline__ unsigned xb_ld(unsigned* p)              { return __hip_atomic_load(p, __ATOMIC_RELAXED, __HIP_MEMORY_SCOPE_AGENT); }
__device__ __forceinline__ unsigned xb_add(unsigned* p, unsigned v) { return __hip_atomic_fetch_add(p, v, __ATOMIC_RELAXED, __HIP_MEMORY_SCOPE_AGENT); }
__device__ __forceinline__ unsigned xb_xcc_id() { return (unsigned)__builtin_amdgcn_s_getreg((3 << 11) | 20) & 0xFu; }
#define XB_SPIN(cond, bar) do { unsigned _sp = 0; while (cond) { __builtin_amdgcn_s_sleep(1); \
    if ((++_sp & 255u) == 0u) { if (xb_ld(&(bar)[XB_TMO])) break; if (_sp > XB_SPIN_CAP) { atomicAdd(&(bar)[XB_TMO], 1u); break; } } } } while (0)

struct XcdBarrier {
    unsigned* bar; unsigned x;
    volatile LAS unsigned* st;
};

__device__ __forceinline__ XcdBarrier xcd_barrier_post(unsigned* bar, volatile LAS unsigned* st, bool leader) {
    XcdBarrier b; b.bar = bar; b.x = xb_xcc_id(); b.st = st;
    if (leader) (void)xb_add(&bar[XB_XCNT(b.x)], 1u);
    return b;
}
__device__ __forceinline__ void xcd_barrier_complete(unsigned* bar, unsigned x, unsigned& nloc, unsigned& nx) {
    const unsigned G = gridDim.x * gridDim.y * gridDim.z;
    unsigned sum, cnt, mine, sp = 0u;
    for (;;) {
        sum = 0u; cnt = 0u; mine = 0u;
#pragma unroll
        for (unsigned j = 0; j < 16; ++j) { const unsigned c = xb_ld(&bar[XB_XCNT(j)]); sum += c; cnt += (c > 0u) ? 1u : 0u; mine = (j == x) ? c : mine; }
        if (sum == G) break;
        __builtin_amdgcn_s_sleep(1);
        if ((++sp & 255u) == 0u) { if (xb_ld(&bar[XB_TMO])) break; if (sp > XB_SPIN_CAP) { atomicAdd(&bar[XB_TMO], 1u); break; } }
    }
    nloc = mine > 0u ? mine : 1u; nx = cnt > 0u ? cnt : 1u;
}

__device__ __forceinline__ void xcd_barrier(const XcdBarrier& b, bool leader) {
    asm volatile("s_waitcnt vmcnt(0)" ::: "memory");
    __syncthreads();
    if (leader) {
        unsigned* bar = b.bar;
        __builtin_amdgcn_s_waitcnt(0);
        unsigned nloc = b.st[0], nx = b.st[1];
        if (nloc == 0u) { xcd_barrier_complete(bar, b.x, nloc, nx); b.st[0] = nloc; b.st[1] = nx; }
        const unsigned old = xb_add(&bar[XB_XSUB(b.x)], 1u);
        const unsigned gen = old / nloc;
        if (old + 1u == (gen + 1u) * nloc) {
            __builtin_amdgcn_fence(__ATOMIC_RELEASE, "agent");
            asm volatile("s_waitcnt vmcnt(0)" ::: "memory");
            const unsigned og = xb_add(&bar[XB_TOP], 1u);
            const unsigned tg = og / nx;
            if (og + 1u == (tg + 1u) * nx) xb_add(&bar[XB_TOPGEN], 1u);
            else XB_SPIN(xb_ld(&bar[XB_TOPGEN]) == tg, bar);
            __builtin_amdgcn_fence(__ATOMIC_ACQUIRE, "agent");
            xb_add(&bar[XB_XGEN(b.x)], 1u);
            asm volatile("s_waitcnt vmcnt(0)" ::: "memory");
        } else {
            XB_SPIN(xb_ld(&bar[XB_XGEN(b.x)]) == gen, bar);
            __builtin_amdgcn_fence(__ATOMIC_ACQUIRE, "agent");
            asm volatile("s_waitcnt vmcnt(0)" ::: "memory");
        }
    }
    __syncthreads();
}

struct Args { const float* in[19]; const int* pos; float* out; unsigned char* ws; };

__device__ __forceinline__ int dst_row(int mode, int n) {
    if (mode == 1) {
        if (n < 1152) return n; const int e = n - 1152, d = e & 31, hf = e >> 5; return 1152 + 8 * (d >> 2) + 4 * hf + (d & 3);
    } else if (mode == 2) {
        const int h = n / 192, e = n - h * 192; if (e < 128) return 128 * h + e; const int ee = e - 128, d = ee & 31, hf = ee >> 5; return 512 + 64 * h + 8 * (d >> 2) + 4 * hf + (d & 3);
    } else if (mode == 3) {
        if (n < DFF) return 256 * (n >> 7) + (n & 127); const int v = n - DFF; return 256 * (v >> 7) + 128 + (v & 127);
    }
    return n;
}
__device__ __forceinline__ void p0_transpose_item(const float* W, int K, int N, const float* gk, bf16* WT, int mode, LAS float* scr, int item, int lane) {
    const int nblk = N / 32, kb = item / nblk, nb = item % nblk, k0 = 64 * kb, n0 = 32 * nb;
#pragma unroll 8
    for (int i = 0; i < 32; ++i) { const int kk = 2 * i + (lane >> 5); float w = W[(size_t)(k0 + kk) * N + n0 + (lane & 31)]; if (gk) w *= gk[k0 + kk]; scr[kk * 33 + (lane & 31)] = w; }
    LDS_WAIT(); asm volatile("" ::: "memory");
    const int c = lane & 7;
#pragma unroll
    for (int j = 0; j < 4; ++j) { const int n = (lane >> 3) + 8 * j; const LAS float* s = scr + (8 * c) * 33 + n;
        v4u o; o.x = pk2(s[0 * 33], s[1 * 33]); o.y = pk2(s[2 * 33], s[3 * 33]); o.z = pk2(s[4 * 33], s[5 * 33]); o.w = pk2(s[6 * 33], s[7 * 33]);
        *(GAS v4u*)(WT + (size_t)dst_row(mode, n0 + n) * K + k0 + 8 * c) = o; }
    LDS_WAIT(); asm volatile("" ::: "memory");
}
__device__ __forceinline__ void rms_row_to_bf16(const float* xrow, const float* g, bf16* orow, int lane) {
    const GAS f32x4* xr = (const GAS f32x4*)xrow + lane; const GAS f32x4* gr = (const GAS f32x4*)g + lane;
    f32x4 v[4]; float s = 0.f;
#pragma unroll
    for (int j = 0; j < 4; ++j) { v[j] = xr[64 * j]; s += (v[j].x * v[j].x + v[j].y * v[j].y) + (v[j].z * v[j].z + v[j].w * v[j].w); }
    const float rstd = 1.f / sqrtf(wave_sum(s) * (1.f / DM) + 1e-6f);
    GAS unsigned long long* o8 = (GAS unsigned long long*)orow + lane;
#pragma unroll
    for (int j = 0; j < 4; ++j) { const f32x4 gg = gr[64 * j];
        o8[64 * j] = (unsigned long long)pk2(v[j].x * rstd * gg.x, v[j].y * rstd * gg.y) | ((unsigned long long)pk2(v[j].z * rstd * gg.z, v[j].w * rstd * gg.w) << 32); }
}
__device__ __forceinline__ int t5_bucket(int n) {
    if (n < 16) return n;
    int l = 16 + (int)(logf((float)n / 16.0f) / 2.0794415416798357f * 16.0f); return l < 31 ? l : 31;
}

typedef const __attribute__((address_space(4))) Args* KArgs;
__device__ __forceinline__ KArgs kargs_now() { KArgs p = (KArgs)__builtin_amdgcn_kernarg_segment_ptr(); asm volatile("" : "+s"(p)); return p; }
#define PTRS() KArgs A_ = kargs_now(); unsigned char* ws = A_->ws; (void)ws
#define SSQ_Q ((float*)(ws + WS_CTL))
#define SSQ_KV (SSQ_Q + MTOK)
#define SSQ2 (SSQ_Q + 2 * MTOK)
#define SSQ3 (SSQ_Q + 3 * MTOK)
#define P_BIAS2 ((float*)(ws + WS_BIAS))
#define P_W_IN_T ((bf16*)(ws + WS_WIN))
#define P_W_QB_T ((bf16*)(ws + WS_WQB))
#define P_W_KVB_T ((bf16*)(ws + WS_WKVB))
#define P_W_OUT_T ((bf16*)(ws + WS_WOUT))
#define P_W_UP_T ((bf16*)(ws + WS_WUP))
#define P_W_DOWN_T ((bf16*)(ws + WS_WDOWN))
#define P_CS ((float*)(ws + WS_CS))
#define P_H0 ((bf16*)(ws + WS_H0))
#define P_QA ((bf16*)(ws + WS_QA))
#define P_KA ((bf16*)(ws + WS_KA))
#define P_VA ((bf16*)(ws + WS_VA))
#define P_CQ ((bf16*)(ws + WS_CQ))
#define P_CKV ((bf16*)(ws + WS_CKV))
#define P_QB ((bf16*)(ws + WS_QB))
#define P_KB ((bf16*)(ws + WS_KB))
#define P_VB ((bf16*)(ws + WS_VB))
#define P_MIX ((bf16*)(ws + WS_MIX))
#define P_ACT ((bf16*)(ws + WS_ACT))
#define P_U ((bf16*)(ws + WS_U))
#define P_EDGE ((float*)(ws + WS_EDGE))

__global__ void __launch_bounds__(NWAVES * 64, 2) hymba_fwd(Args args) {
    extern __shared__ __attribute__((aligned(16))) unsigned char lds[];
    const int wave = __builtin_amdgcn_readfirstlane(threadIdx.x >> 6);
#define LANE_NOW(var) int var; asm volatile("v_mbcnt_lo_u32_b32 %0, -1, 0\n\tv_mbcnt_hi_u32_b32 %0, -1, %0" : "=v"(var))
    { LANE_NOW(l0_); if (wave == 0 && l0_ < 16) ((volatile LAS unsigned*)((LAS unsigned char*)lds + MISC_OFF))[l0_] = 0u; }
    __syncthreads();
#define GEO() int G = gridDim.x; asm volatile("" : "+s"(G)); int bx = blockIdx.x; asm volatile("" : "+s"(bx)); \
    const int vcu = (G % 8 == 0) ? (bx % 8) * (G / 8) + bx / 8 : bx, gw = vcu * NWAVES + wave, NGW = G * NWAVES, NGT = NGW * 64; (void)gw; (void)NGW; (void)NGT; (void)vcu
#define MK_XBAR(xb_) XcdBarrier xb_; { KArgs Ab_ = kargs_now(); xb_.bar = (unsigned*)(Ab_->ws + WS_BAR); xb_.x = xb_xcc_id(); xb_.st = (volatile LAS unsigned*)((LAS unsigned char*)lds + MISC_OFF); }
    { MK_XBAR(xb0_); LANE_NOW(l0_); if (wave == 0 && l0_ == 0) (void)xb_add(&xb0_.bar[XB_XCNT(xb0_.x)], 1u); }
#define GRID_BAR() do { MK_XBAR(xbb_); LANE_NOW(lb_); xcd_barrier(xbb_, wave == 0 && lb_ == 0); } while (0)

#ifndef NO_P0
    {   GEO();
    {
        PTRS(); const float* x = A_->in[0]; const float* rel_bias = A_->in[2]; const float* attn_g = A_->in[3]; const float* w_in = A_->in[4];
        const float* q_norm_g = A_->in[6]; const float* w_q_b = A_->in[7]; const float* kv_norm_g = A_->in[8]; const float* w_kv_b = A_->in[9]; const float* w_out = A_->in[12];
        const float* ffn_g = A_->in[13]; const float* w_up = A_->in[14]; const float* w_down = A_->in[17]; const int* pos = A_->pos;
        bf16* W_IN_T = P_W_IN_T; bf16* W_QB_T = P_W_QB_T; bf16* W_KVB_T = P_W_KVB_T; bf16* W_OUT_T = P_W_OUT_T; bf16* W_UP_T = P_W_UP_T; bf16* W_DOWN_T = P_W_DOWN_T; bf16* H0 = P_H0; float* CS = P_CS; float* bias2 = P_BIAS2;
        LANE_NOW(lane); const int gt = gw * 64 + lane;
        LAS float* scr = (LAS float*)((LAS unsigned char*)lds + wave * 16384);
        constexpr int I_IN = (DM / 64) * (IN_COLS / 32), I_QB = (QL / 64) * (QB_N / 32), I_KVB = (KVL / 64) * (KVB_N / 32), I_OUT = (DM / 64) * (DM / 32),
                      I_UP = (DM / 64) * (UP_N / 32), I_DOWN = (DFF / 64) * (DM / 32);
        constexpr int NITEMS = I_IN + I_QB + I_KVB + I_OUT + I_UP + I_DOWN;
        for (int it = gw; it < NITEMS; it += NGW) {
            int r = it;
            if (r < I_IN) { p0_transpose_item(w_in, DM, IN_COLS, nullptr, W_IN_T, 1, scr, r, lane); continue; } r -= I_IN;
            if (r < I_QB) { p0_transpose_item(w_q_b, QL, QB_N, q_norm_g, W_QB_T, 2, scr, r, lane); continue; } r -= I_QB;
            if (r < I_KVB) { p0_transpose_item(w_kv_b, KVL, KVB_N, kv_norm_g, W_KVB_T, 0, scr, r, lane); continue; } r -= I_KVB;
            if (r < I_OUT) { p0_transpose_item(w_out, DM, DM, nullptr, W_OUT_T, 0, scr, r, lane); continue; } r -= I_OUT;
            if (r < I_UP) { p0_transpose_item(w_up, DM, UP_N, ffn_g, W_UP_T, 3, scr, r, lane); continue; } r -= I_UP;
            p0_transpose_item(w_down, DFF, DM, nullptr, W_DOWN_T, 0, scr, r, lane);
        }
        for (int i = gt; i < (IN_N - IN_COLS) * DM / 8; i += NGT) ((GAS v4u*)(W_IN_T + (size_t)IN_COLS * DM))[i] = (v4u){0u, 0u, 0u, 0u};
        for (int m = gw; m < MTOK; m += NGW) rms_row_to_bf16(x + (size_t)m * DM, attn_g, H0 + (size_t)m * DM, lane);
        for (int i = gt; i < MTOK * 32; i += NGT) { const int t = i >> 5, d = i & 31;
            const float inv_freq = exp2f(-(float)d * (13.287712379549449f / 32.0f));
            const float ang = (float)pos[t] * inv_freq;
            double rev = (double)ang * 0.15915494309189535; rev -= rint(rev);
            const float fr = (float)rev;
            CS[(size_t)t * 64 + d] = __builtin_amdgcn_cosf(fr); CS[(size_t)t * 64 + 32 + d] = __builtin_amdgcn_sinf(fr); }
        for (int i = gt; i < 8 * 128; i += NGT) { const int h = i >> 7, dist = i & 127; bias2[i] = rel_bias[t5_bucket(dist) * 8 + h] * LOG2E_F; }
    }
    GRID_BAR();

    }
#endif
#ifndef NO_P1
    {   GEO();
    {
        PTRS();
        pg8::Gemm g{P_H0, P_W_IN_T, MTOK, IN_N, DM}; pg8::StaticOrder S; S.init(MTOK, IN_N, G, bx);
        pg8::EpiInProj E{P_QA, P_KA, P_VA, P_CQ, P_CKV, P_KB, SSQ_Q, SSQ_KV, P_CS};
        pg8::gemm_phase<pg8::EpiInProj, pg8::StaticOrder, true, true>((LAS unsigned char*)lds, g, S, E, wave);
    }
    GRID_BAR();

    }
#endif
#ifndef NO_P2
    {   GEO();
#ifndef NO_QB
    {
        PTRS();
        pg8::Gemm g{P_CQ, P_W_QB_T, MTOK, QB_N, QL}; pg8::StaticOrder S; S.init(MTOK, QB_N, G, bx);
        pg8::EpiQB E{P_QB, SSQ_Q, P_CS};
        pg8::gemm_phase<pg8::EpiQB, pg8::StaticOrder, true, true>((LAS unsigned char*)lds, g, S, E, wave);
    }
#endif
#ifndef NO_KVB
    {
        PTRS();
        pg8::Gemm g{P_CKV, P_W_KVB_T, MTOK, KVB_N, KVL}; pg8::StaticOrder S; S.init(MTOK, KVB_N, G, bx);
        pg8::EpiKVB E{P_KB, P_VB, SSQ_KV};
        pg8::gemm_phase<pg8::EpiKVB, pg8::StaticOrder, true, true>((LAS unsigned char*)lds, g, S, E, wave);
    }
#endif
    GRID_BAR();

    }
#endif
#ifndef NO_P3
    {   GEO();
#ifndef NO_MLA
    {
        PTRS(); bf16* QBb = P_QB; bf16* KBb = P_KB; bf16* VBb = P_VB; bf16* MIX = P_MIX;
        using BB = att::Body<192, 128, 768, 768, 512, 1024, false, MLA_NQR>;
        static_assert(BB::LDS_BYTES <= MISC_OFF, "attention LDS");
        constexpr int NQB = SEQ / 256, NIT = BATCH * 4 * (NQB / 2);
        for (int L = vcu; L < NIT; L += G)
            for (int pass = 0; pass < 2; ++pass) {
                const int bh = L / (NQB / 2), xq = L % (NQB / 2), b = bh >> 2, h = bh & 3, qb = pass ? NQB - 1 - xq : xq;
                BB::Ref r; const size_t row0 = (size_t)b * SEQ;
                r.Q = QBb + (row0 + (size_t)qb * 256) * 768 + 192 * h; r.K = KBb + row0 * 768 + 192 * h; r.V = VBb + row0 * 512 + 128 * h;
                r.O = MIX + (row0 + (size_t)qb * 256) * 1024 + 512 + 128 * h; r.P0 = qb * 256; r.bias = nullptr; r.sink = 0.f;
                BB::block(r, SEQ, SEQ, (char*)lds, wave);
            }
    }
#endif
#if PROBE_MLA_REPS == 2
#ifndef NO_MLA
    {
        PTRS(); bf16* QBb = P_QB; bf16* KBb = P_KB; bf16* VBb = P_VB; bf16* MIX = P_MIX;
        using BB = att::Body<192, 128, 768, 768, 512, 1024, false, MLA_NQR>;
        static_assert(BB::LDS_BYTES <= MISC_OFF, "attention LDS");
        constexpr int NQB = SEQ / 256, NIT = BATCH * 4 * (NQB / 2);
        for (int L = vcu; L < NIT; L += G)
            for (int pass = 0; pass < 2; ++pass) {
                const int bh = L / (NQB / 2), xq = L % (NQB / 2), b = bh >> 2, h = bh & 3, qb = pass ? NQB - 1 - xq : xq;
                BB::Ref r; const size_t row0 = (size_t)b * SEQ;
                r.Q = QBb + (row0 + (size_t)qb * 256) * 768 + 192 * h; r.K = KBb + row0 * 768 + 192 * h; r.V = VBb + row0 * 512 + 128 * h;
                r.O = MIX + (row0 + (size_t)qb * 256) * 1024 + 512 + 128 * h; r.P0 = qb * 256; r.bias = nullptr; r.sink = 0.f;
                BB::block(r, SEQ, SEQ, (char*)lds, wave);
            }
    }
#endif
#endif
#ifndef NO_SWA
    {
        PTRS(); bf16* QA = P_QA; bf16* KA = P_KA; bf16* VA = P_VA; bf16* MIX = P_MIX; const float* bias2 = P_BIAS2; const float* sinks = A_->in[5];
        using BA = att::Body<64, 64, 512, 128, 128, 1024, true, 4>;
        constexpr int NQB = SEQ / 256, NIT = BATCH * 8 * NQB;
        for (int L = vcu; L < NIT; L += G) {
            const int bh = L / NQB, qb = L % NQB, b = bh >> 3, h = bh & 7;
            BA::Ref r; const size_t row0 = (size_t)b * SEQ;
            r.Q = QA + (row0 + (size_t)qb * 256) * 512 + 64 * h; r.K = KA + row0 * 128 + 64 * (h >> 2); r.V = VA + row0 * 128 + 64 * (h >> 2);
            r.O = MIX + (row0 + (size_t)qb * 256) * 1024 + 64 * h; r.P0 = qb * 256; r.bias = bias2 + 128 * h; r.sink = sinks[h] * LOG2E_F;
            BA::block(r, SEQ, 128, (char*)lds, wave);
        }
    }
#endif
#if PROBE_SWA_REPS == 2
#ifndef NO_SWA
    {
        PTRS(); bf16* QA = P_QA; bf16* KA = P_KA; bf16* VA = P_VA; bf16* MIX = P_MIX; const float* bias2 = P_BIAS2; const float* sinks = A_->in[5];
        using BA = att::Body<64, 64, 512, 128, 128, 1024, true, 4>;
        constexpr int NQB = SEQ / 256, NIT = BATCH * 8 * NQB;
        for (int L = vcu; L < NIT; L += G) {
            const int bh = L / NQB, qb = L % NQB, b = bh >> 3, h = bh & 7;
            BA::Ref r; const size_t row0 = (size_t)b * SEQ;
            r.Q = QA + (row0 + (size_t)qb * 256) * 512 + 64 * h; r.K = KA + row0 * 128 + 64 * (h >> 2); r.V = VA + row0 * 128 + 64 * (h >> 2);
            r.O = MIX + (row0 + (size_t)qb * 256) * 1024 + 64 * h; r.P0 = qb * 256; r.bias = bias2 + 128 * h; r.sink = sinks[h] * LOG2E_F;
            BA::block(r, SEQ, 128, (char*)lds, wave);
        }
    }
#endif
#endif
    GRID_BAR();

    }
#endif
#ifndef NO_P4
    {   GEO();
    { PTRS(); bf16* MIX = P_MIX; const float* a_out_g = A_->in[10]; const float* b_out_g = A_->in[11]; LANE_NOW(lane);
    for (int m = gw; m < MTOK; m += NGW) {
        GAS v4u* p = (GAS v4u*)(MIX + (size_t)m * 1024) + 2 * lane;
        const v4u a = p[0], b = p[1]; float f[16];
        const unsigned wv[8] = {a.x, a.y, a.z, a.w, b.x, b.y, b.z, b.w};
#pragma unroll
        for (int j = 0; j < 8; ++j) { f[2 * j] = __builtin_bit_cast(float, wv[j] << 16); f[2 * j + 1] = __builtin_bit_cast(float, wv[j] & 0xffff0000u); }
        float s = 0.f;
#pragma unroll
        for (int j = 0; j < 16; ++j) s += f[j] * f[j];
#pragma unroll
        for (int o = 1; o < 32; o <<= 1) s += __shfl_xor(s, o);
        const float rs = 1.f / sqrtf(s * (1.f / 512.f) + 1e-6f);
        const float* gp = (lane < 32 ? a_out_g : b_out_g) + 16 * (lane & 31);
        unsigned ow[8];
#pragma unroll
        for (int j = 0; j < 8; ++j) ow[j] = pk2(f[2 * j] * rs * gp[2 * j], f[2 * j + 1] * rs * gp[2 * j + 1]);
        p[0] = (v4u){ow[0], ow[1], ow[2], ow[3]}; p[1] = (v4u){ow[4], ow[5], ow[6], ow[7]};
    } }
    GRID_BAR();

    }
#endif
#ifndef NO_P5
    {   GEO();
    {
        PTRS();
        pg8::Gemm g{P_MIX, P_W_OUT_T, MTOK, DM, DM}; pg8::StaticOrder S; S.init(MTOK, DM, G, bx);
        pg8::EpiOut E{A_->in[0], A_->out, P_H0, SSQ2};
        pg8::gemm_phase<pg8::EpiOut, pg8::StaticOrder, true, true>((LAS unsigned char*)lds, g, S, E, wave);
    }
    GRID_BAR();

    }
#endif
#ifndef NO_P6
    {   GEO();
    {
        PTRS();
        pg8::Gemm g{P_H0, P_W_UP_T, MTOK, UP_N, DM}; pg8::StaticOrder S; S.init(MTOK, UP_N, G, bx);
        pg8::EpiUpConv E{P_ACT, P_EDGE, SSQ2, A_->in[15], A_->in[16]};
        pg8::gemm_phase<pg8::EpiUpConv, pg8::StaticOrder, UP_ALIGN, true>((LAS unsigned char*)lds, g, S, E, wave);
    }
    GRID_BAR();
    {
        PTRS(); const float* EDGE = P_EDGE; bf16* ACT = P_ACT; const float* conv_w = A_->in[15]; const float* conv_b = A_->in[16];
        LANE_NOW(lane); const int gt = gw * 64 + lane;
        for (int it = gt; it < (MTOK / 64) * DFF; it += NGT) {
            const int chunk = it / DFF, j = it - chunk * DFF, pn = j >> 7, col = j & 127;
            const float* e1 = EDGE + ((size_t)(chunk * 22 + pn) * 4) * 256 + col;
            float gm2 = 0.f, gm1 = 0.f, vm2 = 0.f, vm1 = 0.f;
            if ((chunk & (SEQ / 64 - 1)) != 0) { const float* e0 = e1 - (size_t)22 * 4 * 256; gm2 = e0[2 * 256]; gm1 = e0[3 * 256]; vm2 = e0[2 * 256 + 128]; vm1 = e0[3 * 256 + 128]; }
            const float g0 = e1[0], g1 = e1[256], v0 = e1[128], v1 = e1[256 + 128];
            const float wg0 = conv_w[j], wg1 = conv_w[UP_N + j], wg2 = conv_w[2 * UP_N + j], bg = conv_b[j];
            const float wv0 = conv_w[DFF + j], wv1 = conv_w[UP_N + DFF + j], wv2 = conv_w[2 * UP_N + DFF + j], bv = conv_b[DFF + j];
            const float ga = wg0 * gm2 + wg1 * gm1 + wg2 * g0 + bg, va = wv0 * vm2 + wv1 * vm1 + wv2 * v0 + bv;
            const float gb = wg0 * gm1 + wg1 * g0 + wg2 * g1 + bg, vb = wv0 * vm1 + wv1 * v0 + wv2 * v1 + bv;
            const float ra = ga * __builtin_amdgcn_rcpf(1.f + __builtin_amdgcn_exp2f(-ga * LOG2E_F)) * va;
            const float rb = gb * __builtin_amdgcn_rcpf(1.f + __builtin_amdgcn_exp2f(-gb * LOG2E_F)) * vb;
            ACT[(size_t)(chunk * 64) * DFF + j] = (bf16)f2bf(ra); ACT[(size_t)(chunk * 64 + 1) * DFF + j] = (bf16)f2bf(rb);
        }
    }
    GRID_BAR();
    }
#endif
#ifndef NO_P7
    {   GEO();
    {
        PTRS();
        pg8::Gemm g{P_ACT, P_W_DOWN_T, MTOK, DM, DFF}; pg8::StaticOrder S; S.init(MTOK, DM, G, bx);
        pg8::EpiDown E{A_->out, SSQ3};
        pg8::gemm_phase<pg8::EpiDown, pg8::StaticOrder, true, true>((LAS unsigned char*)lds, g, S, E, wave);
    }
    GRID_BAR();

    }
#endif
#ifndef NO_P8
    {   GEO();
    { PTRS(); float* out = A_->out; const float* final_g = A_->in[18]; const float* ssq3 = SSQ3; LANE_NOW(lane);
    for (int m = gw; m < MTOK; m += NGW) {
        GAS f32x4* xr = (GAS f32x4*)(out + (size_t)m * DM) + lane; const GAS f32x4* gr = (const GAS f32x4*)final_g + lane;
        const float rs = 1.f / sqrtf(ssq3[m] * (1.f / DM) + 1e-6f);
#pragma unroll
        for (int j = 0; j < 4; ++j) { const f32x4 v = xr[64 * j], gg = gr[64 * j]; xr[64 * j] = v * rs * gg; }
    } }
    }
#endif
}

extern "C" void kernel_launch(void* const* d_in, const int* in_sizes, int n_in, void* d_out, int out_size, void* d_ws, size_t ws_size, hipStream_t stream) {
    static int grid = 0;
    if (grid == 0) {
        if (n_in != 19 || in_sizes[0] != MTOK * DM || out_size != MTOK * DM || ws_size < WS_END) {
            fprintf(stderr, "kernel_launch: unexpected shapes (n_in %d, in0 %d, out %d, ws %zu)\n", n_in, n_in > 0 ? in_sizes[0] : -1, out_size, ws_size); grid = -1; return; }
        int dev = 0, cus = 0, per_cu = 0;
        (void)hipGetDevice(&dev); (void)hipDeviceGetAttribute(&cus, hipDeviceAttributeMultiprocessorCount, dev);
        if (hipFuncSetAttribute((const void*)hymba_fwd, hipFuncAttributeMaxDynamicSharedMemorySize, LDS_BYTES) != hipSuccess) { fprintf(stderr, "kernel_launch: hipFuncSetAttribute failed\n"); grid = -1; return; }
        if (hipOccupancyMaxActiveBlocksPerMultiprocessor(&per_cu, (const void*)hymba_fwd, NWAVES * 64, LDS_BYTES) != hipSuccess || per_cu < 1) { fprintf(stderr, "kernel_launch: occupancy query says %d\n", per_cu); per_cu = 1; }
        (void)hipGetLastError();
        grid = cus * 1;
        if (grid <= 0) grid = 256;
    }
    if (grid < 0) return;
    (void)hipMemsetAsync((char*)d_ws + WS_CTL, 0, CTL_ZERO_BYTES, stream);
    Args a{};
    for (int i = 0; i < 19; ++i) a.in[i] = (const float*)d_in[i];
    a.pos = (const int*)d_in[1]; a.out = (float*)d_out; a.ws = (unsigned char*)d_ws;
    void* kargs[] = {&a};
    hipError_t e = hipLaunchCooperativeKernel((const void*)hymba_fwd, dim3(grid), dim3(NWAVES * 64), kargs, LDS_BYTES, stream);
    if (e != hipSuccess) fprintf(stderr, "kernel_launch: cooperative launch failed: %s (grid %d)\n", hipGetErrorString(e), grid);
}
```
